# Optimizing an MI355X kernel written in HIP

```python
import math
import jax, jax.numpy as jnp
from jax import lax
import numpy as np

D_MODEL = 2048
BATCH = 4
SEQ = 2048
DEPTH = 2
DEC_BATCH = 16
DEC_SEQ = 32
PAST_LEN = 4096

CHUNK = 64
MIX_WIDTH = D_MODEL
HGRN_WIDTH = MIX_WIDTH // 2
HGRN_HEAD_DIM = 128
HGRN_HEADS = HGRN_WIDTH // HGRN_HEAD_DIM
S5_WIDTH = MIX_WIDTH - HGRN_WIDTH
S5_GROUP = 16
S5_GROUPS = S5_WIDTH // S5_GROUP
S5_STATE = 64
D_FF = 4 * D_MODEL
IN_COLS = 4 * HGRN_WIDTH + S5_WIDTH
EPS = 1e-6
DT_MIN = 1e-3
DT_MAX = 1e-1

kernel_name = "hymba_hgrn2_s5_streaming_step"


def rmsnorm(x, g):
    x32 = x.astype(jnp.float32)
    y = x32 * lax.rsqrt(jnp.mean(jnp.square(x32), axis=-1, keepdims=True) + EPS)
    return (y * g.astype(jnp.float32)).astype(x.dtype)


def _to_blocks(a, L):
    B, T, H, K = a.shape
    return a.reshape(B, T // L, L, H, K).transpose(1, 0, 3, 2, 4)


def hgrn_recurrence(q, k, v, logf, S0, L):
    B, T, H, K = q.shape
    V = v.shape[-1]
    causal = jnp.tril(jnp.ones((L, L), dtype=bool))

    def step(S, blk):
        qb, kb, vb, gb = blk
        cum = jnp.cumsum(gb, axis=2)
        diff = cum[:, :, :, None, :] - cum[:, :, None, :, :]
        decay = jnp.where(causal[None, None, :, :, None], jnp.exp(jnp.minimum(diff, 0.0)), 0.0)
        attn = jnp.einsum('bhtk,bhsk,bhtsk->bhts', qb, kb, decay)
        o = (jnp.einsum('bhts,bhsv->bhtv', attn, vb)
             + jnp.einsum('bhtk,bhkv->bhtv', qb * jnp.exp(cum), S))
        last = cum[:, :, -1:, :]
        S_new = (jnp.exp(last[:, :, 0, :])[..., None] * S
                 + jnp.einsum('bhsk,bhsv->bhkv', kb * jnp.exp(last - cum), vb))
        return S_new, o

    blocks = (_to_blocks(q, L), _to_blocks(k, L), _to_blocks(v, L), _to_blocks(logf, L))
    S_fin, o = lax.scan(step, S0, blocks)
    o = o.transpose(1, 0, 3, 2, 4).reshape(B, T, H, V)
    return o, S_fin


def hgrn_mixer(q_raw, f_raw, i_raw, g_raw, lb, onorm_g, S0):
    B, T, _ = q_raw.shape
    shp = (B, T, HGRN_HEADS, HGRN_HEAD_DIM)
    f32 = jnp.float32
    q = jax.nn.silu(q_raw.astype(f32)).reshape(shp)
    lbv = lb.astype(f32).reshape(HGRN_HEADS, HGRN_HEAD_DIM)
    logf = jnp.logaddexp(jnp.log(lbv),
                         jnp.log1p(-lbv) + jax.nn.log_sigmoid(f_raw.astype(f32).reshape(shp)))
    k = -jnp.expm1(logf)
    v = i_raw.astype(f32).reshape(shp)
    L = min(CHUNK, T)
    o, S = hgrn_recurrence(q, k, v, logf, S0.astype(f32), L)
    o = o * lax.rsqrt(jnp.mean(jnp.square(o), axis=-1, keepdims=True) + EPS)
    o = o * onorm_g.astype(f32).reshape(HGRN_HEADS, HGRN_HEAD_DIM)
    o = o.reshape(B, T, HGRN_WIDTH) * jax.nn.silu(g_raw.astype(f32))
    return o, S


def _ssm_combine(e1, e2):
    a1r, a1i, b1r, b1i = e1
    a2r, a2i, b2r, b2i = e2
    return (a2r * a1r - a2i * a1i,
            a2r * a1i + a2i * a1r,
            a2r * b1r - a2i * b1i + b2r,
            a2r * b1i + a2i * b1r + b2i)


def s5_mixer(u_raw, x0r, x0i, lam_re, lam_im, log_step, B_re, B_im, C_re, C_im, D, w_glu, b_glu):
    f32 = jnp.float32
    Bsz, T, _ = u_raw.shape
    u = u_raw.astype(f32)
    ug = u.reshape(Bsz, T, S5_GROUPS, S5_GROUP)
    lr, li = lam_re.astype(f32), lam_im.astype(f32)
    dt = jnp.exp(log_step.astype(f32))[:, None]
    mag = jnp.exp(dt * lr)
    lbr, lbi = mag * jnp.cos(dt * li), mag * jnp.sin(dt * li)
    nr, ni = lbr - 1.0, lbi
    den = lr * lr + li * li
    cr, ci = (nr * lr + ni * li) / den, (ni * lr - nr * li) / den
    Br, Bi = B_re.astype(f32), B_im.astype(f32)
    Bbr = cr[..., None] * Br - ci[..., None] * Bi
    Bbi = cr[..., None] * Bi + ci[..., None] * Br
    bu_r = jnp.einsum('btgc,gnc->btgn', ug, Bbr)
    bu_i = jnp.einsum('btgc,gnc->btgn', ug, Bbi)
    x0r, x0i = x0r.astype(f32), x0i.astype(f32)
    bu_r = bu_r.at[:, 0].add(lbr * x0r - lbi * x0i)
    bu_i = bu_i.at[:, 0].add(lbr * x0i + lbi * x0r)
    ar = jnp.broadcast_to(lbr, bu_r.shape)
    ai = jnp.broadcast_to(lbi, bu_i.shape)
    _, _, xr, xi = lax.associative_scan(_ssm_combine, (ar, ai, bu_r, bu_i), axis=1)
    y = (jnp.einsum('btgn,gcn->btgc', xr, C_re.astype(f32))
         - jnp.einsum('btgn,gcn->btgc', xi, C_im.astype(f32)))
    y = y + D.astype(f32).reshape(S5_GROUPS, S5_GROUP) * ug
    y = y.reshape(Bsz, T, S5_WIDTH)
    hh = jax.nn.gelu(y)
    out = hh * jax.nn.sigmoid(hh @ w_glu.astype(f32) + b_glu.astype(f32))
    return out, xr[:, -1], xi[:, -1]


def trunk(x, st_h, st_r, st_i, norm1_g, w_in, lb_all, hgrn_onorm_g, s5_lambda_re, s5_lambda_im,
          s5_log_step, s5_B_re, s5_B_im, s5_C_re, s5_C_im, s5_D, s5_w_glu, s5_b_glu, w_out,
          norm2_g, w_ff1, w_ff2, final_norm_g):
    new_h, new_r, new_i = [], [], []
    splits = [HGRN_WIDTH, 2 * HGRN_WIDTH, 3 * HGRN_WIDTH, 4 * HGRN_WIDTH]
    for l in range(DEPTH):
        h = rmsnorm(x, norm1_g[l])
        p = jnp.einsum('btd,dc->btc', h, w_in[l])
        q_raw, f_raw, i_raw, g_raw, u_raw = jnp.split(p, splits, axis=-1)
        o_h, S = hgrn_mixer(q_raw, f_raw, i_raw, g_raw, lb_all[l], hgrn_onorm_g[l], st_h[l])
        o_s, xr, xi = s5_mixer(u_raw, st_r[l], st_i[l], s5_lambda_re[l], s5_lambda_im[l],
                               s5_log_step[l], s5_B_re[l], s5_B_im[l], s5_C_re[l], s5_C_im[l],
                               s5_D[l], s5_w_glu[l], s5_b_glu[l])
        mix = jnp.concatenate([o_h, o_s], axis=-1).astype(x.dtype)
        x = x + jnp.einsum('btc,cd->btd', mix, w_out[l])
        h2 = rmsnorm(x, norm2_g[l])
        a = jax.nn.relu(jnp.einsum('btd,df->btf', h2, w_ff1[l]))
        x = x + jnp.einsum('btf,fd->btd', jnp.square(a), w_ff2[l])
        new_h.append(S)
        new_r.append(xr)
        new_i.append(xi)
    y = rmsnorm(x, final_norm_g)
    return y, jnp.stack(new_h), jnp.stack(new_r), jnp.stack(new_i)


def setup_inputs(seed: int = 0) -> dict:
    key = jax.random.key(seed)
    ks = jax.random.split(key, 32)
    f32 = jnp.float32
    nrm = lambda k, shp, s: jax.random.normal(k, shp, f32) * s
    n_idx = jnp.arange(S5_STATE, dtype=f32)
    inputs = {
        "x_prompt": nrm(ks[0], (BATCH, SEQ, D_MODEL), 1.0),
        "x_sample": nrm(ks[1], (DEC_BATCH, DEC_SEQ, D_MODEL), 1.0),
        "state_hgrn": nrm(ks[2], (DEPTH, DEC_BATCH, HGRN_HEADS, HGRN_HEAD_DIM, HGRN_HEAD_DIM), 0.5),
        "state_s5_re": nrm(ks[3], (DEPTH, DEC_BATCH, S5_GROUPS, S5_STATE), 0.1),
        "state_s5_im": nrm(ks[4], (DEPTH, DEC_BATCH, S5_GROUPS, S5_STATE), 0.1),
        "norm1_g": 1.0 + nrm(ks[5], (DEPTH, D_MODEL), 0.02),
        "w_in": nrm(ks[6], (DEPTH, D_MODEL, IN_COLS), D_MODEL ** -0.5),
        "hgrn_lb_logits": nrm(ks[7], (DEPTH, HGRN_WIDTH), 0.5),
        "hgrn_onorm_g": 1.0 + nrm(ks[8], (DEPTH, HGRN_WIDTH), 0.02),
        "s5_lambda_re": -0.5 + nrm(ks[9], (DEPTH, S5_GROUPS, S5_STATE), 0.01),
        "s5_lambda_im": math.pi * n_idx + nrm(ks[10], (DEPTH, S5_GROUPS, S5_STATE), 0.01),
        "s5_log_step": jax.random.uniform(ks[11], (DEPTH, S5_GROUPS), f32,
                                          math.log(DT_MIN), math.log(DT_MAX)),
        "s5_B_re": nrm(ks[12], (DEPTH, S5_GROUPS, S5_STATE, S5_GROUP), (2 * S5_GROUP) ** -0.5),
        "s5_B_im": nrm(ks[13], (DEPTH, S5_GROUPS, S5_STATE, S5_GROUP), (2 * S5_GROUP) ** -0.5),
        "s5_C_re": nrm(ks[14], (DEPTH, S5_GROUPS, S5_GROUP, S5_STATE), S5_STATE ** -0.5),
        "s5_C_im": nrm(ks[15], (DEPTH, S5_GROUPS, S5_GROUP, S5_STATE), S5_STATE ** -0.5),
        "s5_D": nrm(ks[16], (DEPTH, S5_WIDTH), 1.0),
        "s5_w_glu": nrm(ks[17], (DEPTH, S5_WIDTH, S5_WIDTH), S5_WIDTH ** -0.5),
        "s5_b_glu": nrm(ks[18], (DEPTH, S5_WIDTH), 0.01),
        "w_out": nrm(ks[19], (DEPTH, MIX_WIDTH, D_MODEL), MIX_WIDTH ** -0.5),
        "norm2_g": 1.0 + nrm(ks[20], (DEPTH, D_MODEL), 0.02),
        "w_ff1": nrm(ks[21], (DEPTH, D_MODEL, D_FF), D_MODEL ** -0.5),
        "w_ff2": nrm(ks[22], (DEPTH, D_FF, D_MODEL), 0.5 * D_FF ** -0.5),
        "final_norm_g": 1.0 + nrm(ks[23], (D_MODEL,), 0.02),
    }
    return inputs


def reference(x_prompt, x_sample, state_hgrn, state_s5_re, state_s5_im, norm1_g, w_in,
              hgrn_lb_logits, hgrn_onorm_g, s5_lambda_re, s5_lambda_im, s5_log_step, s5_B_re,
              s5_B_im, s5_C_re, s5_C_im, s5_D, s5_w_glu, s5_b_glu, w_out, norm2_g, w_ff1,
              w_ff2, final_norm_g):
    f32 = jnp.float32
    cum = jnp.cumsum(jax.nn.softmax(hgrn_lb_logits.astype(f32), axis=0), axis=0)
    lb_all = cum - cum[0:1]
    weights = (norm1_g, w_in, lb_all, hgrn_onorm_g, s5_lambda_re, s5_lambda_im, s5_log_step,
               s5_B_re, s5_B_im, s5_C_re, s5_C_im, s5_D, s5_w_glu, s5_b_glu, w_out, norm2_g,
               w_ff1, w_ff2, final_norm_g)
    Bp = x_prompt.shape[0]
    zh = jnp.zeros((DEPTH, Bp, HGRN_HEADS, HGRN_HEAD_DIM, HGRN_HEAD_DIM), f32)
    zs = jnp.zeros((DEPTH, Bp, S5_GROUPS, S5_STATE), f32)
    y_prompt, hp, rp, ip = trunk(x_prompt, zh, zs, zs, *weights)
    y_sample, hs, rs, is_ = trunk(x_sample, state_hgrn, state_s5_re, state_s5_im, *weights)
    return (y_prompt, y_sample, hp, rp, ip, hs, rs, is_)
```

```cpp
#include <hip/hip_runtime.h>
#include <hip/hip_cooperative_groups.h>
#include <cstdio>
#include <cstdint>
namespace cg = cooperative_groups;

#ifndef ONE_LAUNCH
#define ONE_LAUNCH 1
#endif

#ifndef MIX_MASK
#define MIX_MASK 3
#endif
#ifndef EXTRA_BARS
#define EXTRA_BARS 0
#endif
#ifndef BAR_SLEEP
#define BAR_SLEEP 1
#endif
#ifndef PH_MASK
#define PH_MASK 0x1ff
#endif
#define LAS __attribute__((address_space(3)))
typedef unsigned short bf16_t;
typedef short bf16x8 __attribute__((ext_vector_type(8)));
typedef float f32x4 __attribute__((ext_vector_type(4)));
typedef unsigned u32x4 __attribute__((ext_vector_type(4)));
typedef unsigned u32x2 __attribute__((ext_vector_type(2)));

constexpr int D = 2048, M = 8704, DFF = 8192, INC = 5120, NPH = 21;
constexpr float EPS = 1e-6f;
constexpr size_t OUT_HP = 17825792, OUT_RP = 18874368, OUT_IP = 18907136, OUT_HS = 18939904, OUT_RS = 23134208, OUT_IS = 23265280;
constexpr size_t SZ_WIN = (size_t)INC * D * 2, SZ_WGLU = (size_t)1024 * 1024 * 2, SZ_WOUT = (size_t)D * D * 2, SZ_WFF1 = (size_t)DFF * D * 2, SZ_WFF2 = (size_t)D * DFF * 2;
constexpr size_t OFF_WIN = 0, OFF_WGLU = OFF_WIN + 2 * SZ_WIN, OFF_WOUT = OFF_WGLU + 2 * SZ_WGLU, OFF_WFF1 = OFF_WOUT + 2 * SZ_WOUT, OFF_WFF2 = OFF_WFF1 + 2 * SZ_WFF1;
constexpr size_t OFF_H = OFF_WFF2 + 2 * SZ_WFF2, OFF_MIX = OFF_H + (size_t)M * D * 2, OFF_HH = OFF_MIX + (size_t)M * D * 2, OFF_LB = OFF_HH + (size_t)M * 1024 * 2;
constexpr size_t OFF_R = OFF_LB + 8192;
constexpr size_t OFF_Q = OFF_R, OFF_LOGF = OFF_Q + (size_t)M * 1024 * 4, OFF_U = OFF_LOGF + (size_t)M * 1024 * 4, OFF_V = OFF_U + (size_t)M * 1024 * 4, OFF_G = OFF_V + (size_t)M * 1024 * 2;
constexpr size_t OFF_SP = OFF_H;
constexpr size_t OFF_DS = OFF_MIX;
constexpr size_t OFF_DEC = OFF_H + 33554432, OFF_S5E = OFF_DEC + 1048576;
static_assert(OFF_S5E + 1048576 <= OFF_MIX, "H tail");
constexpr size_t OFF_BAR = OFF_R + (size_t)M * DFF * 2;
constexpr size_t WS_END = OFF_BAR + 8192;
static_assert(OFF_G + (size_t)M * 1024 * 2 <= OFF_BAR, "overlay");

constexpr int LDS_BYTES = 154112;

struct Params {
    const float *x_prompt, *x_sample, *state_hgrn, *state_re, *state_im, *norm1_g, *w_in, *lb_logits, *onorm_g, *lam_re, *lam_im, *log_step,
        *B_re, *B_im, *C_re, *C_im, *s5_D, *w_glu, *b_glu, *w_out, *norm2_g, *w_ff1, *w_ff2, *final_g;
    float* out;
    unsigned char* ws;
    int ph_lo, ph_hi;
};

typedef __bf16 bf16x2_t __attribute__((ext_vector_type(2)));
__device__ __forceinline__ unsigned pk2(float lo, float hi) { bf16x2_t v; v.x = (__bf16)lo; v.y = (__bf16)hi; return __builtin_bit_cast(unsigned, v); }
__device__ __forceinline__ float bf_lo(unsigned w) { return __uint_as_float(w << 16); }
__device__ __forceinline__ float bf_hi(unsigned w) { return __uint_as_float(w & 0xffff0000u); }
__device__ __forceinline__ float sigmoidf_(float z) { return 1.0f / (1.0f + __expf(-z)); }
__device__ __forceinline__ float siluf_(float z) { return z / (1.0f + __expf(-z)); }
__device__ __forceinline__ int otid() { int t = threadIdx.x; asm volatile("" : "+v"(t)); return t; }
__device__ __forceinline__ int obid() { int t = blockIdx.x; asm volatile("" : "+s"(t)); return t; }
__device__ __forceinline__ float ld_dev_f32(const float* q) { return *q; }
__device__ __forceinline__ void st_dev_f32(float* q, float v) { *q = v; }
__device__ __forceinline__ u32x2 ld_dev_u32x2(const void* q) { return *(const u32x2*)q; }
__device__ __forceinline__ void st_dev_u32x2(void* q, u32x2 v) { *(u32x2*)q = v; }
#define MFMA_SETTLE() do { __builtin_amdgcn_sched_barrier(0); asm volatile("s_nop 15\n\ts_nop 15\n\ts_nop 15\n\ts_nop 15" ::: "memory"); __builtin_amdgcn_sched_barrier(0); } while (0)
#define LDS_FENCE() asm volatile("s_waitcnt lgkmcnt(0)" ::: "memory")

namespace pg8 {
constexpr int BM = 256, BK = 64, HALF = 128, HTB = HALF * BK * 2, STAGE_BYTES = 8 * HTB, NXCD = 8, WGM = 8;
__host__ __device__ __forceinline__ int lds_byte(int r, int c) { const int st = (r >> 4) * 2 + (c >> 5), rr = r & 15, cc = c & 31, ob = rr * 64 + cc * 2; return st * 1024 + (ob ^ (((ob >> 9) & 1) << 5)); }
__host__ __device__ __forceinline__ void stage_rc(int b, int& R, int& C) { const int st = b / 1024, sb = b % 1024, swz = sb ^ (((sb >> 9) & 1) << 5); R = (st >> 1) * 16 + swz / 64; C = (st & 1) * 32 + (swz % 64) / 2; }
__host__ __device__ __forceinline__ int perm32(int rho) { const int n = rho >> 4, i = rho & 15; return 8 * (i >> 2) + 4 * n + (i & 3); }
struct Unit { int pm, pn; };
struct Gemm { const bf16_t* A; const bf16_t* Bt; int M, N, K, LD; };
struct StaticOrder {
    int nM, nN, nwg, G, c;
    __host__ __device__ void init(int M_, int N_, int G_, int c_) { nM = M_ / BM; nN = N_ / BM; nwg = nM * nN; G = G_; c = c_; }
    __host__ __device__ bool next(int i, Unit& u) const {
        const long L = (long)i * G + c; if (L >= nwg) return false;
        int wgid = (int)L; { const int q = nwg / NXCD, r = nwg % NXCD, xcd = wgid % NXCD, off = wgid / NXCD; wgid = (xcd < r ? xcd * (q + 1) : r * (q + 1) + (xcd - r) * q) + off; }
        const int nig = WGM * nN, gid = wgid / nig, fm = gid * WGM, gsz = (nM - fm) < WGM ? (nM - fm) : WGM;
        u.pm = fm + ((wgid % nig) % gsz); u.pn = (wgid % nig) / gsz; return true;
    }
    __device__ __forceinline__ void a_ready(const Unit&) const {}
    __device__ __forceinline__ void done(const Unit&) const {}
};

struct OneUnit {
    Unit u; bool valid;
    __device__ __forceinline__ bool next(int i, Unit& o) const { if (i != 0 || !valid) return false; o = u; return true; }
    __device__ __forceinline__ void a_ready(const Unit&) const {}
    __device__ __forceinline__ void done(const Unit&) const {}
};

template <class Epi, class Sched, bool ALIGN_EPI = true, bool SP2 = true>
__device__ __forceinline__ void gemm_phase(LAS unsigned char* lds, const Gemm g, const Sched& S, const Epi& E) {
    const int tid = otid(), wid = __builtin_amdgcn_readfirstlane(tid >> 6), lane = tid & 63, wr = wid >> 2, wc = wid & 3, fr = lane & 15, fq = lane >> 4;
    const int K = g.K, LD = g.LD, nt = K / BK;
    unsigned voffA[2], voffB[2];
#pragma unroll
    for (int i = 0; i < 2; ++i) { int R, C; stage_rc(tid * 16 + i * 8192, R, C); const int Rb = Epi::PERM ? ((R & ~31) + perm32(R & 31)) : R;
        voffA[i] = (unsigned)(R * LD + C) * 2u; voffB[i] = (unsigned)(Rb * LD + C) * 2u; }
    const size_t kstep = (size_t)(BK * 2);
    const size_t hstep = (size_t)HALF * LD * 2;
    const size_t tstep = 2 * hstep;
    const unsigned ldsw = (unsigned)wid * 1024u;
    const int aoff = lds_byte(wr * 64 + fr, fq * 8), boff = lds_byte(wc * 32 + fr, fq * 8);
#define PG8_SA(b, h) (((b) * 2 + (h)) * HTB)
#define PG8_SB(b, h) ((4 + (b) * 2 + (h)) * HTB)
#define PG8_STAGE(bufoff, gbase, voff) do { _Pragma("unroll") for (int _i = 0; _i < 2; ++_i) \
        __builtin_amdgcn_global_load_lds((const unsigned*)((const char*)(gbase) + (voff)[_i]), (LAS unsigned*)(lds + (bufoff) + ldsw + _i * 8192), 16, 0, 0); } while (0)
#define PG8_LDA(dst, b, h) do { _Pragma("unroll") for (int m = 0; m < 4; ++m) _Pragma("unroll") for (int k = 0; k < 2; ++k) dst[m][k] = *(const LAS bf16x8*)(lds + PG8_SA(b, h) + aoff + m * 2048 + k * 1024); } while (0)
#define PG8_LDB(dst, b, h) do { _Pragma("unroll") for (int n = 0; n < 2; ++n) _Pragma("unroll") for (int k = 0; k < 2; ++k) dst[n][k] = *(const LAS bf16x8*)(lds + PG8_SB(b, h) + boff + n * 2048 + k * 1024); } while (0)
#define PG8_MMA(ai, bj, At, Bt) do { __builtin_amdgcn_s_setprio(1); _Pragma("unroll") for (int m = 0; m < 4; ++m) _Pragma("unroll") for (int n = 0; n < 2; ++n) _Pragma("unroll") for (int k = 0; k < 2; ++k) \
        acc[ai][bj][m][n] = __builtin_amdgcn_mfma_f32_16x16x32_bf16(Bt[n][k], At[m][k], acc[ai][bj][m][n], 0, 0, 0); __builtin_amdgcn_s_setprio(0); } while (0)
#define PG8_WAIT_V(n) asm volatile("s_waitcnt vmcnt(" #n ")" ::: "memory")
#define PG8_WAIT_L(n) asm volatile("s_waitcnt lgkmcnt(" #n ")" ::: "memory")
#define PG8_BAR __builtin_amdgcn_s_barrier()
#define PG8_SCHED __builtin_amdgcn_sched_barrier(0)
    Unit cur, nxt; int ui = 0;
    if (!S.next(0, cur)) return;
    f32x4 acc[2][2][4][2];
#pragma unroll
    for (int a = 0; a < 2; ++a)
#pragma unroll
        for (int b = 0; b < 2; ++b)
#pragma unroll
            for (int m = 0; m < 4; ++m)
#pragma unroll
                for (int n = 0; n < 2; ++n) acc[a][b][m][n] = (f32x4){0.f, 0.f, 0.f, 0.f};
    bf16x8 At[4][2], B0[2][2], B1[2][2];
    const char* cA = (const char*)g.A + (size_t)cur.pm * tstep; const char* cB = (const char*)g.Bt + (size_t)cur.pn * tstep;
    S.a_ready(cur);
    if constexpr (SP2) {
        PG8_STAGE(PG8_SB(0, 0), cB, voffB); PG8_STAGE(PG8_SB(0, 1), cB + hstep, voffB); PG8_STAGE(PG8_SA(0, 0), cA, voffA); PG8_STAGE(PG8_SA(0, 1), cA + hstep, voffA);
        if (wr == 1) PG8_BAR;
        PG8_WAIT_V(2); PG8_BAR;
        PG8_STAGE(PG8_SB(1, 0), cB + kstep, voffB); PG8_STAGE(PG8_SA(1, 0), cA + kstep, voffA); PG8_STAGE(PG8_SB(1, 1), cB + hstep + kstep, voffB);
        PG8_WAIT_V(6); PG8_BAR;
    } else {
        PG8_STAGE(PG8_SB(0, 0), cB, voffB); PG8_STAGE(PG8_SA(0, 0), cA, voffA); PG8_STAGE(PG8_SB(0, 1), cB + hstep, voffB); PG8_STAGE(PG8_SA(0, 1), cA + hstep, voffA);
        if (wr == 1) PG8_BAR;
        PG8_WAIT_V(4); PG8_BAR;
        PG8_STAGE(PG8_SB(1, 0), cB + kstep, voffB); PG8_STAGE(PG8_SA(1, 0), cA + kstep, voffA); PG8_STAGE(PG8_SB(1, 1), cB + hstep + kstep, voffB);
        PG8_WAIT_V(6); PG8_BAR;
    }
    for (;;) {
        const bool has_next = S.next(ui + 1, nxt);
        const char* nA = has_next ? (const char*)g.A + (size_t)nxt.pm * tstep : cA; const char* nB = has_next ? (const char*)g.Bt + (size_t)nxt.pn * tstep : cB;
        for (int t = 0; t < nt; t += 2) {
            const bool last = (t == nt - 2);
            const char* a1 = cA + (size_t)(t + 1) * kstep;
            const char* a2 = last ? nA : cA + (size_t)(t + 2) * kstep; const char* b2 = last ? nB : cB + (size_t)(t + 2) * kstep;
            const char* a3 = a2 + kstep; const char* b3 = b2 + kstep;
            if (last && has_next) S.a_ready(nxt);
            if constexpr (SP2) {
            PG8_LDB(B0, 0, 0); PG8_LDB(B1, 0, 1); PG8_SCHED; PG8_LDA(At, 0, 0); PG8_STAGE(PG8_SA(1, 1), a1 + hstep, voffA);
            PG8_WAIT_V(8); PG8_WAIT_L(0); PG8_BAR; PG8_MMA(0, 0, At, B0); PG8_MMA(0, 1, At, B1); PG8_BAR; PG8_SCHED;
            PG8_LDA(At, 0, 1); PG8_STAGE(PG8_SB(0, 0), b2, voffB); PG8_STAGE(PG8_SB(0, 1), b2 + hstep, voffB); PG8_STAGE(PG8_SA(0, 0), a2, voffA);
            PG8_WAIT_V(8); PG8_WAIT_L(0); PG8_BAR; PG8_MMA(1, 0, At, B0); PG8_MMA(1, 1, At, B1); PG8_BAR; PG8_SCHED;
            PG8_LDB(B0, 1, 0); PG8_LDB(B1, 1, 1); PG8_SCHED; PG8_LDA(At, 1, 0); PG8_STAGE(PG8_SA(0, 1), a2 + hstep, voffA);
            PG8_WAIT_V(8); PG8_WAIT_L(0); PG8_BAR; PG8_MMA(0, 0, At, B0); PG8_MMA(0, 1, At, B1); PG8_BAR; PG8_SCHED;
            PG8_LDA(At, 1, 1); PG8_STAGE(PG8_SB(1, 0), b3, voffB); PG8_STAGE(PG8_SB(1, 1), b3 + hstep, voffB); PG8_STAGE(PG8_SA(1, 0), a3, voffA);
            PG8_WAIT_V(8); PG8_WAIT_L(0); PG8_BAR; PG8_MMA(1, 0, At, B0); PG8_MMA(1, 1, At, B1); PG8_BAR; PG8_SCHED;
            } else {
            PG8_LDB(B0, 0, 0); PG8_SCHED; PG8_LDA(At, 0, 0); PG8_STAGE(PG8_SA(1, 1), a1 + hstep, voffA);
            PG8_WAIT_L(8); PG8_BAR; PG8_WAIT_L(0); PG8_MMA(0, 0, At, B0); PG8_BAR; PG8_SCHED;
            PG8_LDB(B1, 0, 1); PG8_STAGE(PG8_SB(0, 0), b2, voffB);
            PG8_BAR; PG8_WAIT_L(0); PG8_MMA(0, 1, At, B1); PG8_BAR;
            PG8_LDA(At, 0, 1); PG8_STAGE(PG8_SA(0, 0), a2, voffA);
            PG8_BAR; PG8_WAIT_L(0); PG8_MMA(1, 0, At, B0); PG8_BAR; PG8_SCHED;
            PG8_STAGE(PG8_SB(0, 1), b2 + hstep, voffB);
            PG8_WAIT_V(6); PG8_BAR; PG8_MMA(1, 1, At, B1); PG8_BAR;
            PG8_LDB(B0, 1, 0); PG8_SCHED; PG8_LDA(At, 1, 0); PG8_STAGE(PG8_SA(0, 1), a2 + hstep, voffA);
            PG8_WAIT_L(8); PG8_BAR; PG8_WAIT_L(0); PG8_MMA(0, 0, At, B0); PG8_BAR; PG8_SCHED;
            PG8_LDB(B1, 1, 1); PG8_STAGE(PG8_SB(1, 0), b3, voffB);
            PG8_BAR; PG8_WAIT_L(0); PG8_MMA(0, 1, At, B1); PG8_BAR;
            PG8_LDA(At, 1, 1); PG8_STAGE(PG8_SA(1, 0), a3, voffA);
            PG8_BAR; PG8_WAIT_L(0); PG8_MMA(1, 0, At, B0); PG8_BAR; PG8_SCHED;
            PG8_STAGE(PG8_SB(1, 1), b3 + hstep, voffB);
            PG8_WAIT_V(6); PG8_BAR; PG8_MMA(1, 1, At, B1); PG8_BAR;
            }
        }
        if constexpr (ALIGN_EPI) { if (wr == 0) PG8_BAR; }
        MFMA_SETTLE();
        E(acc, cur, wr, wc, fr, fq); S.done(cur);
        if (!has_next) break;
#pragma unroll
        for (int a = 0; a < 2; ++a)
#pragma unroll
            for (int b = 0; b < 2; ++b)
#pragma unroll
                for (int m = 0; m < 4; ++m)
#pragma unroll
                    for (int n = 0; n < 2; ++n) acc[a][b][m][n] = (f32x4){0.f, 0.f, 0.f, 0.f};
        cur = nxt; cA = nA; cB = nB; ++ui;
        if constexpr (ALIGN_EPI) { if (wr == 1) PG8_BAR; }
    }
    PG8_WAIT_V(0);
    if constexpr (!ALIGN_EPI) { if (wr == 0) PG8_BAR; }
    PG8_BAR;
#undef PG8_SA
#undef PG8_SB
#undef PG8_STAGE
#undef PG8_LDA
#undef PG8_LDB
#undef PG8_MMA
#undef PG8_WAIT_V
#undef PG8_WAIT_L
#undef PG8_BAR
#undef PG8_SCHED
}
}

typedef f32x4 AccT[2][2][4][2];

struct EpiIn {
    static constexpr bool PERM = true;
    float *Q, *LOGF, *U; bf16_t *V, *G; const float* LB;
    __device__ __forceinline__ void operator()(const AccT& acc, const pg8::Unit& u, int wr, int wc, int fr, int fq) const {
        const int row0 = u.pm * 256 + wr * 64 + fr, sect = u.pn >> 2, colb = (u.pn & 3) * 256 + wc * 32 + 8 * fq;
        if (false) {
        } else if (sect == 1) {
            f32x4 lb[2][2];
#pragma unroll
            for (int bj = 0; bj < 2; ++bj)
#pragma unroll
                for (int n = 0; n < 2; ++n) lb[bj][n] = *(const f32x4*)(LB + colb + bj * 128 + n * 4);
#pragma unroll
            for (int ai = 0; ai < 2; ++ai)
#pragma unroll
                for (int m = 0; m < 4; ++m) { float* rp = LOGF + (size_t)(row0 + ai * 128 + m * 16) * 1024 + colb;
#pragma unroll
                    for (int bj = 0; bj < 2; ++bj)
#pragma unroll
                        for (int n = 0; n < 2; ++n) { f32x4 v = acc[ai][bj][m][n], o;
#pragma unroll
                            for (int j = 0; j < 4; ++j) { const float l_ = lb[bj][n][j]; const float f = l_ + (1.0f - l_) * sigmoidf_(v[j]); o[j] = logf(f); }
                            *(f32x4*)(rp + bj * 128 + n * 4) = o; } }
        } else {
            bf16_t* dst = sect == 0 ? (bf16_t*)Q : sect == 2 ? V : sect == 3 ? G : (bf16_t*)U;
#pragma unroll
            for (int ai = 0; ai < 2; ++ai)
#pragma unroll
                for (int m = 0; m < 4; ++m) { bf16_t* rp = dst + (size_t)(row0 + ai * 128 + m * 16) * 1024 + colb;
#pragma unroll
                    for (int bj = 0; bj < 2; ++bj) { f32x4 v0 = acc[ai][bj][m][0], v1 = acc[ai][bj][m][1];
                        if (sect == 0 || sect == 3) {
#pragma unroll
                            for (int j = 0; j < 4; ++j) { v0[j] = siluf_(v0[j]); v1[j] = siluf_(v1[j]); } }
                        u32x4 w; w.x = pk2(v0[0], v0[1]); w.y = pk2(v0[2], v0[3]); w.z = pk2(v1[0], v1[1]); w.w = pk2(v1[2], v1[3]);
                        *(u32x4*)(rp + bj * 128) = w; } }
        }
    }
};
struct EpiGlu {
    static constexpr bool PERM = true;
    bf16_t* MIX; const bf16_t* HH; const float* bias;
    __device__ __forceinline__ void operator()(const AccT& acc, const pg8::Unit& u, int wr, int wc, int fr, int fq) const {
        const int row0 = u.pm * 256 + wr * 64 + fr, colb = u.pn * 256 + wc * 32 + 8 * fq;
        f32x4 bv[2][2];
#pragma unroll
        for (int bj = 0; bj < 2; ++bj)
#pragma unroll
            for (int n = 0; n < 2; ++n) bv[bj][n] = *(const f32x4*)(bias + colb + bj * 128 + n * 4);
#pragma unroll
        for (int ai = 0; ai < 2; ++ai)
#pragma unroll
            for (int m = 0; m < 4; ++m) { const size_t r = (size_t)(row0 + ai * 128 + m * 16);
#pragma unroll
                for (int bj = 0; bj < 2; ++bj) { const u32x4 hw = *(const u32x4*)(HH + r * 1024 + colb + bj * 128);
                    const f32x4 v0 = acc[ai][bj][m][0] + bv[bj][0], v1 = acc[ai][bj][m][1] + bv[bj][1];
                    u32x4 w;
                    w.x = pk2(bf_lo(hw.x) * sigmoidf_(v0[0]), bf_hi(hw.x) * sigmoidf_(v0[1])); w.y = pk2(bf_lo(hw.y) * sigmoidf_(v0[2]), bf_hi(hw.y) * sigmoidf_(v0[3]));
                    w.z = pk2(bf_lo(hw.z) * sigmoidf_(v1[0]), bf_hi(hw.z) * sigmoidf_(v1[1])); w.w = pk2(bf_lo(hw.w) * sigmoidf_(v1[2]), bf_hi(hw.w) * sigmoidf_(v1[3]));
                    *(u32x4*)(MIX + r * 2048 + 1024 + colb + bj * 128) = w; } }
    }
};
struct EpiRes {
    static constexpr bool PERM = true;
    float* X; const float* xp; const float* xs;
    __device__ __forceinline__ void operator()(const AccT& acc, const pg8::Unit& u, int wr, int wc, int fr, int fq) const {
        const int row0 = u.pm * 256 + wr * 64 + fr, colb = u.pn * 256 + wc * 32 + 8 * fq;
        const float* R = xp ? (u.pm < 32 ? xp : xs - (size_t)8192 * 2048) : X;
#pragma unroll
        for (int ai = 0; ai < 2; ++ai)
#pragma unroll
            for (int m = 0; m < 4; ++m) { const size_t ro = (size_t)(row0 + ai * 128 + m * 16) * 2048 + colb;
#pragma unroll
                for (int bj = 0; bj < 2; ++bj)
#pragma unroll
                    for (int n = 0; n < 2; ++n) *(f32x4*)(X + ro + bj * 128 + n * 4) = *(const f32x4*)(R + ro + bj * 128 + n * 4) + acc[ai][bj][m][n]; }
    }
};
struct EpiPart {
    static constexpr bool PERM = true;
    float* P;
    __device__ __forceinline__ void operator()(const AccT& acc, const pg8::Unit& u, int wr, int wc, int fr, int fq) const {
        const int row0 = wr * 64 + fr, colb = wc * 32 + 8 * fq;
#pragma unroll
        for (int ai = 0; ai < 2; ++ai)
#pragma unroll
            for (int m = 0; m < 4; ++m) { float* rp = P + (size_t)(row0 + ai * 128 + m * 16) * 256 + colb;
#pragma unroll
                for (int bj = 0; bj < 2; ++bj)
#pragma unroll
                    for (int n = 0; n < 2; ++n) *(f32x4*)(rp + bj * 128 + n * 4) = acc[ai][bj][m][n]; }
    }
};
struct EpiFF1 {
    static constexpr bool PERM = true;
    bf16_t* ACT;
    __device__ __forceinline__ void operator()(const AccT& acc, const pg8::Unit& u, int wr, int wc, int fr, int fq) const {
        const int row0 = u.pm * 256 + wr * 64 + fr, colb = u.pn * 256 + wc * 32 + 8 * fq;
#pragma unroll
        for (int ai = 0; ai < 2; ++ai)
#pragma unroll
            for (int m = 0; m < 4; ++m) { bf16_t* rp = ACT + (size_t)(row0 + ai * 128 + m * 16) * 8192 + colb;
#pragma unroll
                for (int bj = 0; bj < 2; ++bj) { f32x4 v0 = acc[ai][bj][m][0], v1 = acc[ai][bj][m][1];
#pragma unroll
                    for (int j = 0; j < 4; ++j) { const float a = fmaxf(v0[j], 0.f), b = fmaxf(v1[j], 0.f); v0[j] = a * a; v1[j] = b * b; }
                    u32x4 w; w.x = pk2(v0[0], v0[1]); w.y = pk2(v0[2], v0[3]); w.z = pk2(v1[0], v1[1]); w.w = pk2(v1[2], v1[3]);
                    *(u32x4*)(rp + bj * 128) = w; } }
    }
};

__device__ __forceinline__ float wave_sum(float v) {
#pragma unroll
    for (int o = 1; o < 64; o <<= 1) v += __shfl_xor(v, o);
    return v;
}
__device__ __forceinline__ void rms_row(const float* xrow, const float* g, float* copy_dst, bf16_t* hrow, float* yrow, int lane) {
    f32x4 v[8]; float s = 0.f;
#pragma unroll
    for (int j = 0; j < 8; ++j) { v[j] = *((const f32x4*)xrow + lane + 64 * j); s += (v[j][0] * v[j][0] + v[j][1] * v[j][1]) + (v[j][2] * v[j][2] + v[j][3] * v[j][3]); }
    const float rstd = 1.0f / sqrtf(wave_sum(s) * (1.0f / 2048.0f) + EPS);
#pragma unroll
    for (int j = 0; j < 8; ++j) {
        const f32x4 gg = *((const f32x4*)g + lane + 64 * j);
        if (copy_dst) *((f32x4*)copy_dst + lane + 64 * j) = v[j];
        const f32x4 o = v[j] * rstd * gg;
        if (hrow) { u32x2 w; w.x = pk2(o[0], o[1]); w.y = pk2(o[2], o[3]); *((u32x2*)hrow + lane + 64 * j) = w; }
        if (yrow) *((f32x4*)yrow + lane + 64 * j) = o;
    }
}
__device__ __forceinline__ void transpose_item(const float* W, int K, int N, bf16_t* WT, LAS float* scr, int item, int lane) {
    const int nblk = N / 32, kb = item / nblk, nb = item % nblk, k0 = 64 * kb, n0 = 32 * nb;
    {
        f32x4 t[8];
#pragma unroll
        for (int i = 0; i < 8; ++i) t[i] = *(const f32x4*)(W + (size_t)(k0 + 8 * i + (lane >> 3)) * N + n0 + 4 * (lane & 7));
#pragma unroll
        for (int i = 0; i < 8; ++i) { LAS float* d = scr + (8 * i + (lane >> 3)) * 33 + 4 * (lane & 7); d[0] = t[i][0]; d[1] = t[i][1]; d[2] = t[i][2]; d[3] = t[i][3]; }
    }
    LDS_FENCE();
    const int c = lane & 7;
#pragma unroll
    for (int j = 0; j < 4; ++j) { const int n = (lane >> 3) + 8 * j; const LAS float* s = scr + (8 * c) * 33 + n;
        u32x4 o; o.x = pk2(s[0 * 33], s[1 * 33]); o.y = pk2(s[2 * 33], s[3 * 33]); o.z = pk2(s[4 * 33], s[5 * 33]); o.w = pk2(s[6 * 33], s[7 * 33]);
        *(u32x4*)(WT + (size_t)(n0 + n) * K + k0 + 8 * c) = o; }
    LDS_FENCE();
}
constexpr int I_IN = 32 * 160, I_GLU = 16 * 32, I_OUT = 32 * 64, I_F1 = 32 * 256, I_F2 = 128 * 64, I_L = I_IN + I_GLU + I_OUT + I_F1 + I_F2;
__device__ __forceinline__ void conv_item(const Params& p, LAS float* scr, int l, int r, int lane) {
    if (r < I_IN) { transpose_item(p.w_in + (size_t)l * D * INC, D, INC, (bf16_t*)(p.ws + OFF_WIN + l * SZ_WIN), scr, r, lane); return; } r -= I_IN;
    if (r < I_GLU) { transpose_item(p.w_glu + (size_t)l * 1024 * 1024, 1024, 1024, (bf16_t*)(p.ws + OFF_WGLU + l * SZ_WGLU), scr, r, lane); return; } r -= I_GLU;
    if (r < I_OUT) { transpose_item(p.w_out + (size_t)l * D * D, D, D, (bf16_t*)(p.ws + OFF_WOUT + l * SZ_WOUT), scr, r, lane); return; } r -= I_OUT;
    if (r < I_F1) { transpose_item(p.w_ff1 + (size_t)l * D * DFF, D, DFF, (bf16_t*)(p.ws + OFF_WFF1 + l * SZ_WFF1), scr, r, lane); return; } r -= I_F1;
    transpose_item(p.w_ff2 + (size_t)l * DFF * D, DFF, D, (bf16_t*)(p.ws + OFF_WFF2 + l * SZ_WFF2), scr, r, lane);
}
__device__ __forceinline__ void bg_convert(LAS unsigned char* lds, const Params& p, int first_idle, int l, int start, int count) {
    if (gridDim.x != 256) return;
    const int bid = obid(); if (bid < first_idle) return;
    const int tid = otid(), lane = tid & 63, w = tid >> 6;
    LAS float* scr = (LAS float*)(lds + w * 8448);
    const int nw = (256 - first_idle) * 8;
    for (int i = (bid - first_idle) * 8 + w; i < count; i += nw) conv_item(p, scr, l, start + i, lane);
}
constexpr int BG_A_START = 5632, BG_A_N = 4224, BG_B_START = 9856, BG_B_N = 3840, BG_O_START = 13696, BG_O_N = 1536, BG_P0_START = 15232, BG_P0_N = 640, BG_C_START = 15872, BG_C_N = 8192;
constexpr int BG_C0_EXTRA = 2560, BG_F0_START = 2560, BG_F0_N = 3072;
static_assert(BG_A_START + BG_A_N == BG_B_START && BG_B_START + BG_B_N == BG_O_START && BG_O_START + BG_O_N == BG_P0_START && BG_P0_START + BG_P0_N == BG_C_START && BG_C_START + BG_C_N == I_L, "schedule covers the layer");
static_assert(BG_C0_EXTRA == BG_F0_START && BG_F0_START + BG_F0_N == BG_A_START, "schedule covers layer 1's first matrices");
__device__ __forceinline__ void phase0(LAS unsigned char* lds, const Params& p) {
    const int tid = otid(), lane = tid & 63, w = tid >> 6;
    const int gw = obid() * 8 + w, NGW = gridDim.x * 8;
    LAS float* scr = (LAS float*)(lds + w * 8448);
    if (gridDim.x == 256) {
        for (int it = gw; it < BG_A_START + 2 * BG_P0_N; it += NGW) {
            if (it < BG_A_START) conv_item(p, scr, 0, it, lane);
            else if (it < BG_A_START + BG_P0_N) conv_item(p, scr, 0, BG_P0_START + (it - BG_A_START), lane);
            else conv_item(p, scr, 1, BG_P0_START + (it - BG_A_START - BG_P0_N), lane);
        }
    }
    bf16_t* H = (bf16_t*)(p.ws + OFF_H);
    for (int r = gw; r < M; r += NGW) {
        const float* src = r < 8192 ? p.x_prompt + (size_t)r * D : p.x_sample + (size_t)(r - 8192) * D;
        rms_row(src, p.norm1_g, nullptr, H + (size_t)r * D, nullptr, lane);
    }
    if (obid() == 0) {
        float* LB = (float*)(p.ws + OFF_LB);
        for (int c = tid; c < 1024; c += 512) { const float l0 = p.lb_logits[c], l1 = p.lb_logits[1024 + c]; LB[c] = 0.f; LB[1024 + c] = 1.0f / (1.0f + expf(l0 - l1)); }
    }
}
__device__ __forceinline__ void phase_norm_parts(const Params& p, const float* g, bool final_, const float* part, int splits, bool from_input) {
    const int tid_ = otid(); const int lane = tid_ & 63, w = tid_ >> 6;
    bf16_t* H = (bf16_t*)(p.ws + OFF_H);
    const int G = gridDim.x;
    for (int r = obid() * 8 + w; r < M; r += G * 8) {
        float* xr = p.out + (size_t)r * D;
        const int pm = r >> 8;
        unsigned long long code = 0ull;
        if (G == 256) { for (int j = 0; j < 16; ++j) { pg8::StaticOrder T; T.init(M, D, G, j); pg8::Unit u; T.next(1, u); if (u.pm == pm) code |= (unsigned long long)(j + 1) << (8 * u.pn); } }
        f32x4 v[8]; float s = 0.f;
#pragma unroll
        for (int j = 0; j < 8; ++j) {
            const int lj = (int)((code >> (8 * j)) & 0xffull);
            const float* src = (from_input && lj) ? (r < 8192 ? p.x_prompt + (size_t)r * D : p.x_sample + (size_t)(r - 8192) * D) : xr;
            v[j] = *((const f32x4*)src + lane + 64 * j);
            if (lj) { const float* pp = part + (size_t)(lj - 1) * splits * 65536 + (size_t)(r & 255) * 256 + 4 * lane;
                for (int ks = 0; ks < splits; ++ks) v[j] = v[j] + *(const f32x4*)(pp + (size_t)ks * 65536);
                if (!final_) *((f32x4*)xr + lane + 64 * j) = v[j]; }
            s += (v[j][0] * v[j][0] + v[j][1] * v[j][1]) + (v[j][2] * v[j][2] + v[j][3] * v[j][3]);
        }
        const float rstd = 1.0f / sqrtf(wave_sum(s) * (1.0f / 2048.0f) + EPS);
#pragma unroll
        for (int j = 0; j < 8; ++j) {
            const f32x4 gg = *((const f32x4*)g + lane + 64 * j);
            const f32x4 o = v[j] * rstd * gg;
            if (final_) *((f32x4*)xr + lane + 64 * j) = o;
            else { u32x2 wv; wv.x = pk2(o[0], o[1]); wv.y = pk2(o[2], o[3]); *((u32x2*)(H + (size_t)r * D) + lane + 64 * j) = wv; }
        }
    }
}
__device__ __forceinline__ void phase_norm(const Params& p, const float* g, bool final_) {
    const int tid_ = otid(); const int lane = tid_ & 63, w = tid_ >> 6;
    bf16_t* H = (bf16_t*)(p.ws + OFF_H);
    for (int r = obid() * 8 + w; r < M; r += gridDim.x * 8) {
        float* xr = p.out + (size_t)r * D;
        if (final_) rms_row(xr, g, nullptr, nullptr, xr, lane); else rms_row(xr, g, nullptr, H + (size_t)r * D, nullptr, lane);
    }
}

constexpr int H_QT = 0, H_KT = 17408, H_ATT = 34816, H_VT = 44032, H_ST = 62464, H_KHT = 97280, H_CUM = 115712, H_SEG = 149504, H_SSQ = 153600;
#define MFMA16(a, b, c) __builtin_amdgcn_mfma_f32_16x16x32_bf16(a, b, c, 0, 0, 0)
#define FRAG(off) (*(const LAS bf16x8*)(lds + (off)))
struct HItem { int b, h, nvalid, rbase, pidx; };
__device__ __forceinline__ HItem hgrn_decode(int item) {
    HItem r;
    if (item < 1024) { const int bh = item >> 5, c = item & 31; r.b = bh >> 3; r.h = bh & 7; r.nvalid = 64; r.rbase = r.b * 2048 + c * 64; r.pidx = item; }
    else { const int j = item - 1024; r.b = j >> 3; r.h = j & 7; r.nvalid = 32; r.rbase = 8192 + r.b * 32; r.pidx = -1; }
    return r;
}
__device__ __forceinline__ void hgrn_load_vt(LAS unsigned char* lds, const bf16_t* Vp, int rbase, int nvalid, int tid) {
    const int s = tid & 63, c0 = (tid >> 6) * 16;
    u32x4 v0 = (u32x4){0u, 0u, 0u, 0u}, v1 = v0;
    if (s < nvalid) { const u32x4* vp = (const u32x4*)(Vp + (size_t)(rbase + s) * 1024 + c0); v0 = vp[0]; v1 = vp[1]; }
    LAS unsigned short* vt = (LAS unsigned short*)(lds + H_VT + c0 * 144 + s * 2);
#pragma unroll
    for (int j = 0; j < 4; ++j) { vt[(2 * j) * 72] = (unsigned short)(v0[j] & 0xffffu); vt[(2 * j + 1) * 72] = (unsigned short)(v0[j] >> 16);
        vt[(8 + 2 * j) * 72] = (unsigned short)(v1[j] & 0xffffu); vt[(8 + 2 * j + 1) * 72] = (unsigned short)(v1[j] >> 16); }
}
__device__ __forceinline__ void hgrn_m1_item(LAS unsigned char* lds, const Params& p, int l, int item) {
    const int tid = otid(), lane = tid & 63, w = tid >> 6, q4 = lane >> 4, l15 = lane & 15;
    const HItem I = hgrn_decode(item);
    const float* LFp = (const float*)(p.ws + OFF_LOGF) + I.h * 128;
    const bf16_t* Vp = (const bf16_t*)(p.ws + OFF_V) + I.h * 128;
    LAS float* SEGf = (LAS float*)(lds + H_SEG);
    {
        const int kcol = tid & 127, seg = tid >> 7;
        float lf[16], c[16];
#pragma unroll
        for (int i = 0; i < 16; ++i) { const int t = seg * 16 + i; lf[i] = (t < I.nvalid) ? LFp[(size_t)(I.rbase + t) * 1024 + kcol] : 0.f; }
        hgrn_load_vt(lds, Vp, I.rbase, I.nvalid, tid);
        c[0] = lf[0];
#pragma unroll
        for (int i = 1; i < 16; ++i) c[i] = c[i - 1] + lf[i];
        SEGf[seg * 128 + kcol] = c[15];
        __syncthreads();
        const float s0 = SEGf[kcol], s1 = SEGf[128 + kcol], s2 = SEGf[256 + kcol], s3 = SEGf[384 + kcol];
        const float off = (seg > 0 ? s0 : 0.f) + (seg > 1 ? s1 : 0.f) + (seg > 2 ? s2 : 0.f);
        const float last = (s0 + s1) + (s2 + s3), ref = s0 + s1;
        if (seg == 0) {
            const float el = __expf(last);
            SEGf[768 + kcol] = el;
            if (I.pidx >= 0) { float* dec = (float*)(p.ws + OFF_DEC) + (size_t)I.pidx * 256; st_dev_f32(dec + kcol, el); st_dev_f32(dec + 128 + kcol, __expf(ref)); }
        }
        unsigned pk[8];
#pragma unroll
        for (int i = 0; i < 16; i += 2) {
            const float c0 = off + c[i], c1 = off + c[i + 1];
            const float k0 = (1.0f - __expf(lf[i])) * __expf(last - c0), k1 = (1.0f - __expf(lf[i + 1])) * __expf(last - c1);
            pk[i >> 1] = pk2(k0, k1);
        }
        LAS u32x4* kd = (LAS u32x4*)(lds + H_KHT + kcol * 144 + seg * 32);
        kd[0] = (u32x4){pk[0], pk[1], pk[2], pk[3]}; kd[1] = (u32x4){pk[4], pk[5], pk[6], pk[7]};
    }
    __syncthreads();
    {
        bf16x8 ka[2];
#pragma unroll
        for (int ks = 0; ks < 2; ++ks) ka[ks] = FRAG(H_KHT + (16 * w + l15) * 144 + (32 * ks + 8 * q4) * 2);
        if (I.pidx >= 0) {
            bf16_t* ds = (bf16_t*)(p.ws + OFF_DS) + (size_t)I.pidx * 16384;
#pragma unroll
            for (int vt = 0; vt < 8; ++vt) { f32x4 s = (f32x4){0.f, 0.f, 0.f, 0.f};
#pragma unroll
                for (int ks = 0; ks < 2; ++ks) { const bf16x8 bv = FRAG(H_VT + (16 * vt + l15) * 144 + (32 * ks + 8 * q4) * 2); s = MFMA16(ka[ks], bv, s); }
                MFMA_SETTLE();
                u32x2 o; o.x = pk2(s[0], s[1]); o.y = pk2(s[2], s[3]);
                st_dev_u32x2(ds + (16 * vt + l15) * 128 + 16 * w + 4 * q4, o); }
        } else {
            const f32x4 el = *(const LAS f32x4*)(lds + H_SEG + 3072 + (16 * w + 4 * q4) * 4);
            const float* sin_ = p.state_hgrn + ((size_t)(l * 16 + I.b) * 8 + I.h) * 16384;
            float* sout = p.out + OUT_HS + ((size_t)(l * 16 + I.b) * 8 + I.h) * 16384;
#pragma unroll
            for (int vt = 0; vt < 8; ++vt) { f32x4 s;
#pragma unroll
                for (int j = 0; j < 4; ++j) s[j] = sin_[(16 * w + 4 * q4 + j) * 128 + 16 * vt + l15] * el[j];
#pragma unroll
                for (int ks = 0; ks < 2; ++ks) { const bf16x8 bv = FRAG(H_VT + (16 * vt + l15) * 144 + (32 * ks + 8 * q4) * 2); s = MFMA16(ka[ks], bv, s); }
                MFMA_SETTLE();
#pragma unroll
                for (int j = 0; j < 4; ++j) sout[(16 * w + 4 * q4 + j) * 128 + 16 * vt + l15] = s[j]; }
        }
    }
    __syncthreads();
}
__device__ __forceinline__ void hgrn_m2(const Params& p, int l) {
    const int gt = obid() * 512 + otid(), GT = gridDim.x * 512;
    for (int idx = gt; idx < 32 * 128 * 32; idx += GT) {
        const int bh = idx >> 12, v = (idx >> 5) & 127, k4 = (idx & 31) * 4;
        const bf16_t* ds = (const bf16_t*)(p.ws + OFF_DS) + (size_t)bh * 32 * 16384 + v * 128 + k4;
        const float* dec = (const float*)(p.ws + OFF_DEC) + (size_t)bh * 32 * 256 + k4;
        bf16_t* sp = (bf16_t*)(p.ws + OFF_SP) + (size_t)bh * 32 * 16384 + v * 128 + k4;
        f32x4 S = (f32x4){0.f, 0.f, 0.f, 0.f};
#pragma unroll 8
        for (int c = 0; c < 32; ++c) {
            const u32x2 e0_ = ld_dev_u32x2(dec + c * 256), e1_ = ld_dev_u32x2(dec + c * 256 + 2), r0_ = ld_dev_u32x2(dec + c * 256 + 128), r1_ = ld_dev_u32x2(dec + c * 256 + 130);
            const f32x4 el = (f32x4){__uint_as_float(e0_.x), __uint_as_float(e0_.y), __uint_as_float(e1_.x), __uint_as_float(e1_.y)}, er = (f32x4){__uint_as_float(r0_.x), __uint_as_float(r0_.y), __uint_as_float(r1_.x), __uint_as_float(r1_.y)};
            const u32x2 dw = ld_dev_u32x2(ds + (size_t)c * 16384);
            const f32x4 d4 = (f32x4){bf_lo(dw.x), bf_hi(dw.x), bf_lo(dw.y), bf_hi(dw.y)};
            u32x2 o; o.x = pk2(S[0] * er[0], S[1] * er[1]); o.y = pk2(S[2] * er[2], S[3] * er[3]);
            st_dev_u32x2(sp + (size_t)c * 16384, o);
            S = S * el + d4;
        }
        float* so = p.out + OUT_HP + ((size_t)(l * 32 + bh)) * 16384;
#pragma unroll
        for (int j = 0; j < 4; ++j) so[(k4 + j) * 128 + v] = S[j];
    }
}
__device__ __forceinline__ void hgrn_m3_item(LAS unsigned char* lds, const Params& p, int l, int item) {
    const int tid = otid(), lane = tid & 63, w = tid >> 6, q4 = lane >> 4, l15 = lane & 15;
    const HItem I = hgrn_decode(item);
    const bf16_t* Qp = (const bf16_t*)(p.ws + OFF_Q) + I.h * 128; const float* LFp = (const float*)(p.ws + OFF_LOGF) + I.h * 128;
    const bf16_t* Vp = (const bf16_t*)(p.ws + OFF_V) + I.h * 128; const bf16_t* Gp = (const bf16_t*)(p.ws + OFF_G) + I.h * 128;
    bf16_t* MIXp = (bf16_t*)(p.ws + OFF_MIX) + I.h * 128;
    const float* og = p.onorm_g + l * 1024 + I.h * 128;
    LAS float* SEGf = (LAS float*)(lds + H_SEG); LAS float* CUMf = (LAS float*)(lds + H_CUM); LAS float* SSQf = (LAS float*)(lds + H_SSQ);
    const int rbase = I.rbase, nvalid = I.nvalid;
    const int tB = tid >> 3, k0B = (tid & 7) * 16; const bool validB = tB < nvalid;
    f32x4 qv[4], lv[4];
#pragma unroll
    for (int i = 0; i < 4; ++i) { qv[i] = (f32x4){0.f, 0.f, 0.f, 0.f}; lv[i] = qv[i];
        if (validB) { const u32x2 qw = *(const u32x2*)(Qp + (size_t)(rbase + tB) * 1024 + k0B + 4 * i); qv[i] = (f32x4){bf_lo(qw.x), bf_hi(qw.x), bf_lo(qw.y), bf_hi(qw.y)};
            lv[i] = *(const f32x4*)(LFp + (size_t)(rbase + tB) * 1024 + k0B + 4 * i); } }
    u32x4 spv[4];
    {
        const bool zero = (I.pidx < 0) || ((I.pidx & 31) == 0);
        const char* sp = (const char*)((const bf16_t*)(p.ws + OFF_SP) + (size_t)(I.pidx < 0 ? 0 : I.pidx) * 16384);
#pragma unroll
        for (int i = 0; i < 4; ++i) { const int id = tid + 512 * i; spv[i] = (u32x4){0u, 0u, 0u, 0u};
            if (!zero) spv[i] = *(const u32x4*)(sp + (size_t)id * 16); }
    }
    {
        const int kcol = tid & 127, seg = tid >> 7;
        float c[16];
#pragma unroll
        for (int i = 0; i < 16; ++i) { const int t = seg * 16 + i; c[i] = (t < nvalid) ? LFp[(size_t)(rbase + t) * 1024 + kcol] : 0.f; }
        hgrn_load_vt(lds, Vp, rbase, nvalid, tid);
#pragma unroll
        for (int i = 1; i < 16; ++i) c[i] = c[i - 1] + c[i];
        SEGf[seg * 128 + kcol] = c[15];
        __syncthreads();
        const float s0 = SEGf[kcol], s1 = SEGf[128 + kcol], s2 = SEGf[256 + kcol];
        const float off = (seg > 0 ? s0 : 0.f) + (seg > 1 ? s1 : 0.f) + (seg > 2 ? s2 : 0.f);
        const float ref = s0 + s1;
        if (seg == 0) { SEGf[512 + kcol] = ref; SEGf[640 + kcol] = __expf(ref); }
#pragma unroll
        for (int i = 0; i < 16; ++i) CUMf[(seg * 16 + i) * 132 + kcol] = off + c[i];
    }
    __syncthreads();
    {
        unsigned qpk[8], kpk[8];
#pragma unroll
        for (int i = 0; i < 4; ++i) {
            const f32x4 cu = *(const LAS f32x4*)(lds + H_CUM + (tB * 132 + k0B + 4 * i) * 4), rf = *(const LAS f32x4*)(lds + H_SEG + 2048 + (k0B + 4 * i) * 4);
            float qt[4], kt[4];
#pragma unroll
            for (int j = 0; j < 4; ++j) { const float d = cu[j] - rf[j]; qt[j] = qv[i][j] * __expf(d); kt[j] = (1.0f - __expf(lv[i][j])) * __expf(-d); }
            qpk[2 * i] = pk2(qt[0], qt[1]); qpk[2 * i + 1] = pk2(qt[2], qt[3]); kpk[2 * i] = pk2(kt[0], kt[1]); kpk[2 * i + 1] = pk2(kt[2], kt[3]);
        }
        LAS u32x4* qd = (LAS u32x4*)(lds + H_QT + tB * 272 + k0B * 2); qd[0] = (u32x4){qpk[0], qpk[1], qpk[2], qpk[3]}; qd[1] = (u32x4){qpk[4], qpk[5], qpk[6], qpk[7]};
        LAS u32x4* kd = (LAS u32x4*)(lds + H_KT + tB * 272 + k0B * 2); kd[0] = (u32x4){kpk[0], kpk[1], kpk[2], kpk[3]}; kd[1] = (u32x4){kpk[4], kpk[5], kpk[6], kpk[7]};
    }
    if (I.pidx >= 0) {
#pragma unroll
        for (int i = 0; i < 4; ++i) { const int id = tid + 512 * i, row = id >> 4, c16 = id & 15; *(LAS u32x4*)(lds + H_ST + row * 272 + c16 * 16) = spv[i]; }
    } else {
        const float* sin_ = p.state_hgrn + ((size_t)(l * 16 + I.b) * 8 + I.h) * 16384;
        const f32x4 er = *(const LAS f32x4*)(lds + H_SEG + 2560 + (16 * w + 4 * q4) * 4);
#pragma unroll
        for (int vt = 0; vt < 8; ++vt) { float s[4];
#pragma unroll
            for (int j = 0; j < 4; ++j) s[j] = sin_[(16 * w + 4 * q4 + j) * 128 + 16 * vt + l15] * er[j];
            u32x2 o; o.x = pk2(s[0], s[1]); o.y = pk2(s[2], s[3]);
            *(LAS u32x2*)(lds + H_ST + (16 * vt + l15) * 272 + (16 * w + 4 * q4) * 2) = o; }
    }
    __syncthreads();
    {
        const int tt = w >> 1;
#pragma unroll
        for (int u = 0; u < 2; ++u) {
            const int st = 2 * (w & 1) + u;
            u32x2 o = (u32x2){0u, 0u};
            if (st <= tt) {
                f32x4 acc = (f32x4){0.f, 0.f, 0.f, 0.f};
#pragma unroll
                for (int ks = 0; ks < 4; ++ks) { const bf16x8 a = FRAG(H_KT + (16 * st + l15) * 272 + (32 * ks + 8 * q4) * 2), bq = FRAG(H_QT + (16 * tt + l15) * 272 + (32 * ks + 8 * q4) * 2); acc = MFMA16(a, bq, acc); }
                MFMA_SETTLE();
                const int tg = 16 * tt + l15, sg = 16 * st + 4 * q4;
                const float a0 = (sg + 0 <= tg) ? acc[0] : 0.f, a1 = (sg + 1 <= tg) ? acc[1] : 0.f, a2 = (sg + 2 <= tg) ? acc[2] : 0.f, a3 = (sg + 3 <= tg) ? acc[3] : 0.f;
                o.x = pk2(a0, a1); o.y = pk2(a2, a3);
            }
            *(LAS u32x2*)(lds + H_ATT + (16 * tt + l15) * 144 + (16 * st + 4 * q4) * 2) = o;
        }
    }
    __syncthreads();
    f32x4 O[4];
    const int tt = w & 3, vh = w >> 2, t = 16 * tt + l15;
    u32x2 gg[4]; f32x4 g4[4];
#pragma unroll
    for (int i = 0; i < 4; ++i) { const int vb = 16 * (4 * vh + i) + 4 * q4; g4[i] = *(const f32x4*)(og + vb);
        gg[i] = (t < nvalid) ? *(const u32x2*)(Gp + (size_t)(rbase + t) * 1024 + vb) : (u32x2){0u, 0u}; }
    {
        bf16x8 ab[2], qb[4];
#pragma unroll
        for (int ks = 0; ks < 2; ++ks) ab[ks] = FRAG(H_ATT + (16 * tt + l15) * 144 + (32 * ks + 8 * q4) * 2);
#pragma unroll
        for (int ks = 0; ks < 4; ++ks) qb[ks] = FRAG(H_QT + (16 * tt + l15) * 272 + (32 * ks + 8 * q4) * 2);
        float ssq = 0.f;
#pragma unroll
        for (int i = 0; i < 4; ++i) {
            const int vt = 4 * vh + i; f32x4 acc = (f32x4){0.f, 0.f, 0.f, 0.f};
#pragma unroll
            for (int ks = 0; ks < 2; ++ks) { const bf16x8 a = FRAG(H_VT + (16 * vt + l15) * 144 + (32 * ks + 8 * q4) * 2); acc = MFMA16(a, ab[ks], acc); }
#pragma unroll
            for (int ks = 0; ks < 4; ++ks) { const bf16x8 a = FRAG(H_ST + (16 * vt + l15) * 272 + (32 * ks + 8 * q4) * 2); acc = MFMA16(a, qb[ks], acc); }
            MFMA_SETTLE();
            O[i] = acc; ssq += (acc[0] * acc[0] + acc[1] * acc[1]) + (acc[2] * acc[2] + acc[3] * acc[3]);
        }
        ssq += __shfl_xor(ssq, 16); ssq += __shfl_xor(ssq, 32);
        if (q4 == 0) SSQf[vh * 64 + 16 * tt + l15] = ssq;
    }
    __syncthreads();
    {
        const float tot = SSQf[t] + SSQf[64 + t];
        const float rs = 1.0f / sqrtf(tot * (1.0f / 128.0f) + EPS);
        if (t < nvalid) {
#pragma unroll
            for (int i = 0; i < 4; ++i) { const int vb = 16 * (4 * vh + i) + 4 * q4;
                u32x2 o; o.x = pk2(O[i][0] * rs * g4[i][0] * bf_lo(gg[i].x), O[i][1] * rs * g4[i][1] * bf_hi(gg[i].x)); o.y = pk2(O[i][2] * rs * g4[i][2] * bf_lo(gg[i].y), O[i][3] * rs * g4[i][3] * bf_hi(gg[i].y));
                *(u32x2*)(MIXp + (size_t)(rbase + t) * 2048 + vb) = o; }
        }
    }
    __syncthreads();
}

__device__ __forceinline__ void s5_lbar(const Params& p, int gi, int n, float& lbr, float& lbi, float& cr, float& ci) {
    const float dt = expf(p.log_step[gi]);
    const float lr = p.lam_re[gi * 64 + n], li = p.lam_im[gi * 64 + n];
    const float mag = expf(dt * lr), ang = dt * li;
    const float kq = rintf(ang * 0.636619772f);
    float r = fmaf(-kq, 1.57079637f, ang); r = fmaf(-kq, -4.37113883e-8f, r);
    const int qi = ((int)kq) & 3;
    const float r2 = r * r;
    const float sn = r + r * r2 * (-1.66666667e-1f + r2 * (8.33333333e-3f + r2 * (-1.98412698e-4f + r2 * 2.75573192e-6f)));
    const float cs = 1.0f + r2 * (-0.5f + r2 * (4.16666667e-2f + r2 * (-1.38888889e-3f + r2 * (2.48015873e-5f + r2 * -2.75573192e-7f))));
    const float s_ = (qi == 0) ? sn : (qi == 1) ? cs : (qi == 2) ? -sn : -cs;
    const float c_ = (qi == 0) ? cs : (qi == 1) ? -sn : (qi == 2) ? -cs : sn;
    lbr = mag * c_; lbi = mag * s_;
    const float nr = lbr - 1.0f, ni = lbi, den = lr * lr + li * li;
    cr = (nr * lr + ni * li) / den; ci = (ni * lr - nr * li) / den;
}
template <int KIND>
__device__ __forceinline__ void s5_wave(LAS unsigned char* lds  , const Params& p, int l, int b, int g, int cc, int lane) {
    const int n = lane, q4 = lane >> 4, l15 = lane & 15;
    const int nsteps = KIND == 2 ? 32 : 256, row0 = KIND == 2 ? 8192 + b * 32 : b * 2048 + cc * 256;
    const int gi = l * 64 + g;
    float lbr, lbi, cr, ci;
    s5_lbar(p, gi, n, lbr, lbi, cr, ci);
    {
        const f32x4* Brp = (const f32x4*)(p.B_re + ((size_t)gi * 64 + n) * 16); const f32x4* Bip = (const f32x4*)(p.B_im + ((size_t)gi * 64 + n) * 16);
        unsigned re[8], im[8];
#pragma unroll
        for (int i = 0; i < 4; ++i) { const f32x4 br = Brp[i], bi = Bip[i];
            re[2 * i] = pk2(cr * br[0] - ci * bi[0], cr * br[1] - ci * bi[1]); re[2 * i + 1] = pk2(cr * br[2] - ci * bi[2], cr * br[3] - ci * bi[3]);
            im[2 * i] = pk2(cr * bi[0] + ci * br[0], cr * bi[1] + ci * br[1]); im[2 * i + 1] = pk2(cr * bi[2] + ci * br[2], cr * bi[3] + ci * br[3]); }
        LAS u32x4* d0 = (LAS u32x4*)(lds + n * 32); d0[0] = (u32x4){re[0], re[1], re[2], re[3]}; d0[1] = (u32x4){re[4], re[5], re[6], re[7]};
        LAS u32x4* d1 = (LAS u32x4*)(lds + (64 + n) * 32); d1[0] = (u32x4){im[0], im[1], im[2], im[3]}; d1[1] = (u32x4){im[4], im[5], im[6], im[7]};
    }
    LDS_FENCE();
    const bf16x8 zero8 = (bf16x8){0, 0, 0, 0, 0, 0, 0, 0};
    bf16x8 bbf[8];
#pragma unroll
    for (int j = 0; j < 8; ++j) { const bf16x8 t = *(const LAS bf16x8*)(lds + (16 * j + l15) * 32 + (q4 & 1) * 16); bbf[j] = (q4 < 2) ? t : zero8; }
    LDS_FENCE();
    bf16x8 cf[4]; f32x4 dv = (f32x4){0.f, 0.f, 0.f, 0.f};
    if (KIND != 0) {
#pragma unroll
        for (int ks = 0; ks < 4; ++ks) {
            const size_t ci_ = ((size_t)gi * 16 + l15) * 64 + 16 * ks + 4 * q4;
            const f32x4 cr4 = *(const f32x4*)(p.C_re + ci_), ci4 = *(const f32x4*)(p.C_im + ci_);
            const u32x4 wv = (u32x4){pk2(cr4[0], -ci4[0]), pk2(cr4[1], -ci4[1]), pk2(cr4[2], -ci4[2]), pk2(cr4[3], -ci4[3])};
            cf[ks] = __builtin_bit_cast(bf16x8, wv);
        }
        dv = *(const f32x4*)(p.s5_D + l * 1024 + g * 16 + 4 * q4);
    }
    float xr = 0.f, xi = 0.f;
    const size_t eidx = ((size_t)(b * 64 + g) * 8 + cc) * 64 + n;
    if (KIND == 1) {
        float ar = lbr, ai = lbi;
#pragma unroll
        for (int i = 0; i < 8; ++i) { const float nr = ar * ar - ai * ai, ni = 2.0f * ar * ai; ar = nr; ai = ni; }
        const float* se = (const float*)(p.ws + OFF_S5E); const size_t e0 = ((size_t)(b * 64 + g) * 8) * 64 + n;
        for (int j = 0; j < cc; ++j) { const float er = ld_dev_f32(se + e0 + j * 64), ei = ld_dev_f32(se + 131072 + e0 + j * 64);
            const float nxr = ar * xr - ai * xi + er, nxi = ar * xi + ai * xr + ei; xr = nxr; xi = nxi; }
    }
    if (KIND == 2) { xr = p.state_re[((size_t)(l * 16 + b) * 64 + g) * 64 + n]; xi = p.state_im[((size_t)(l * 16 + b) * 64 + g) * 64 + n]; }
    const bf16_t* Up = (const bf16_t*)(p.ws + OFF_U) + g * 16;
    bf16_t* HHp = (bf16_t*)(p.ws + OFF_HH) + g * 16;
    LAS float* BUf = (LAS float*)lds; LAS unsigned short* X16 = (LAS unsigned short*)(lds + 8448);
    u32x4 nu = (u32x4){0u, 0u, 0u, 0u};
    if (q4 < 2) nu = *(const u32x4*)(Up + (size_t)(row0 + l15) * 1024 + 8 * q4);
    for (int t0 = 0; t0 < nsteps; t0 += 16) {
        const bf16x8 uf = __builtin_bit_cast(bf16x8, nu);
        if (q4 < 2 && t0 + 16 < nsteps) nu = *(const u32x4*)(Up + (size_t)(row0 + t0 + 16 + l15) * 1024 + 8 * q4);
        const size_t row = (size_t)(row0 + t0 + l15);
        f32x4 u4 = (f32x4){0.f, 0.f, 0.f, 0.f};
        if (KIND != 0) { const u32x2 uw = *(const u32x2*)(Up + row * 1024 + 4 * q4); u4 = (f32x4){bf_lo(uw.x), bf_hi(uw.x), bf_lo(uw.y), bf_hi(uw.y)}; }
        f32x4 dd[8];
#pragma unroll
        for (int j = 0; j < 8; ++j) dd[j] = MFMA16(bbf[j], uf, ((f32x4){0.f, 0.f, 0.f, 0.f}));
        MFMA_SETTLE();
#pragma unroll
        for (int j = 0; j < 8; ++j) *(LAS f32x4*)(lds + (l15 * 132 + 16 * j + 4 * q4) * 4) = dd[j];
        LDS_FENCE();
#pragma unroll
        for (int t = 0; t < 16; ++t) {
            const float br = BUf[t * 132 + n], bi = BUf[t * 132 + 64 + n];
            const float nxr = fmaf(lbr, xr, fmaf(-lbi, xi, br)), nxi = fmaf(lbr, xi, fmaf(lbi, xr, bi));
            xr = nxr; xi = nxi;
            if (KIND != 0) *(LAS unsigned*)(lds + 8448 + t * 272 + n * 4) = pk2(xr, xi);
        }
        LDS_FENCE();
        if (KIND != 0) {
            f32x4 y = (f32x4){0.f, 0.f, 0.f, 0.f};
#pragma unroll
            for (int ks = 0; ks < 4; ++ks) { const bf16x8 xb = *(const LAS bf16x8*)(lds + 8448 + l15 * 272 + (32 * ks + 8 * q4) * 2); y = MFMA16(cf[ks], xb, y); }
            MFMA_SETTLE();
            LDS_FENCE();
            float hh[4];
#pragma unroll
            for (int j = 0; j < 4; ++j) { const float yy = y[j] + dv[j] * u4[j]; const float a = 0.7978845608028654f * (yy + 0.044715f * yy * yy * yy);
                const float e = __expf(2.0f * a); const float th = 1.0f - 2.0f / (e + 1.0f); hh[j] = 0.5f * yy * (1.0f + th); }
            u32x2 o; o.x = pk2(hh[0], hh[1]); o.y = pk2(hh[2], hh[3]);
            *(u32x2*)(HHp + row * 1024 + 4 * q4) = o;
        }
    }
    if (KIND == 0) { float* se = (float*)(p.ws + OFF_S5E); st_dev_f32(se + eidx, xr); st_dev_f32(se + 131072 + eidx, xi); }
    if (KIND == 1 && cc == 7) { const size_t o = ((size_t)(l * 4 + b) * 64 + g) * 64 + n; p.out[OUT_RP + o] = xr; p.out[OUT_IP + o] = xi; }
    if (KIND == 2) { const size_t idx = ((size_t)(l * 16 + b) * 64 + g) * 64 + n; p.out[OUT_RS + idx] = xr; p.out[OUT_IS + idx] = xi; }
}
__device__ __forceinline__ void phase_mix1(LAS unsigned char* lds, const Params& p, int l) {
    const int tid_ = otid(); const int w = tid_ >> 6, lane = tid_ & 63;
    for (int it = obid(); it < 1152 + 256; it += gridDim.x) {
        if (it < 1152) hgrn_m1_item(lds, p, l, it);
        else { const int id = (it - 1152) * 8 + w;
            s5_wave<0>(lds + w * 12800, p, l, id >> 9, id & 63, (id >> 6) & 7, lane); __syncthreads(); }
    }
}
__device__ __forceinline__ void phase_mix2(const Params& p, int l) { hgrn_m2(p, l); }
__device__ __forceinline__ void phase_mix3(LAS unsigned char* lds, const Params& p, int l) {
    const int tid_ = otid(); const int w = tid_ >> 6, lane = tid_ & 63;
    for (int it = obid(); it < 1152 + 256 + 128; it += gridDim.x) {
        if (it < 1152) hgrn_m3_item(lds, p, l, it);
        else if (it < 1152 + 128) { const int id = (it - 1152) * 8 + w;
            s5_wave<2>(lds + w * 12800, p, l, id >> 6, id & 63, 0, lane); __syncthreads(); }
        else { const int id = (it - 1152 - 128) * 8 + w;
            s5_wave<1>(lds + w * 12800, p, l, id >> 9, id & 63, (id >> 6) & 7, lane); __syncthreads(); }
    }
}

__device__ __forceinline__ void gemm_residual(LAS unsigned char* lds, const Params& p, const bf16_t* A, const bf16_t* Bt, int K, float* part, int splits, bool from_input) {
    const int G = gridDim.x, bid = obid();
    pg8::StaticOrder S; S.init(M, D, G, bid);
    EpiRes E; E.X = p.out; E.xp = from_input ? p.x_prompt : nullptr; E.xs = p.x_sample;
    if (G != 256) { pg8::gemm_phase(lds, pg8::Gemm{A, Bt, M, D, K, K}, S, E); return; }
    pg8::OneUnit S1; S1.valid = S.next(0, S1.u);
    pg8::gemm_phase(lds, pg8::Gemm{A, Bt, M, D, K, K}, S1, E);
    const int j = bid / splits, ks = bid % splits, Ksub = K / splits;
    pg8::OneUnit S2; S2.valid = false;
    if (j < 16) { pg8::StaticOrder T; T.init(M, D, G, j); S2.valid = T.next(1, S2.u); }
    EpiPart EP; EP.P = part + (size_t)(j * splits + ks) * 65536;
    pg8::gemm_phase(lds, pg8::Gemm{A + (size_t)ks * Ksub, Bt + (size_t)ks * Ksub, M, D, Ksub, K}, S2, EP);
}

__device__ __forceinline__ void run_phase(LAS unsigned char* lds, const Params& p, int ph) {
    if (ph == 0) { if (PH_MASK & 256) phase0(lds, p); return; }
    const int l = (ph - 1) / 10, s = (ph - 1) % 10;
    pg8::StaticOrder S;
    bf16_t* H = (bf16_t*)(p.ws + OFF_H); bf16_t* MIX = (bf16_t*)(p.ws + OFF_MIX); bf16_t* HH = (bf16_t*)(p.ws + OFF_HH); bf16_t* ACT = (bf16_t*)(p.ws + OFF_R);
    switch (s) {
    case 0: if (PH_MASK & 1) { S.init(M, INC, gridDim.x, obid());
        EpiIn E; E.Q = (float*)(p.ws + OFF_Q); E.LOGF = (float*)(p.ws + OFF_LOGF); E.U = (float*)(p.ws + OFF_U); E.V = (bf16_t*)(p.ws + OFF_V); E.G = (bf16_t*)(p.ws + OFF_G); E.LB = (const float*)(p.ws + OFF_LB) + l * 1024;
        pg8::gemm_phase(lds, pg8::Gemm{H, (const bf16_t*)(p.ws + OFF_WIN + l * SZ_WIN), M, INC, D, D}, S, E);
        bg_convert(lds, p, 168, l, BG_A_START, BG_A_N); } break;
    case 1: if (PH_MASK & 2) phase_mix1(lds, p, l); break;
    case 2: if (PH_MASK & 2) phase_mix2(p, l); break;
    case 3: if (PH_MASK & 2) phase_mix3(lds, p, l); break;
    case 4: if (PH_MASK & 4) { S.init(M, 1024, gridDim.x, obid());
        EpiGlu E; E.MIX = MIX; E.HH = HH; E.bias = p.b_glu + l * 1024;
        pg8::gemm_phase(lds, pg8::Gemm{HH, (const bf16_t*)(p.ws + OFF_WGLU + l * SZ_WGLU), M, 1024, 1024, 1024}, S, E);
        bg_convert(lds, p, 136, l, BG_B_START, BG_B_N); } break;
    case 5: if (PH_MASK & 8) { gemm_residual(lds, p, MIX, (const bf16_t*)(p.ws + OFF_WOUT + l * SZ_WOUT), D, (float*)(p.ws + OFF_HH), 4, l == 0);
        bg_convert(lds, p, 64, l, BG_O_START, BG_O_N); } break;
    case 6: if (PH_MASK & 16) phase_norm_parts(p, p.norm2_g + l * D, false, (const float*)(p.ws + OFF_HH), 4, l == 0); break;
    case 7: if (PH_MASK & 32) { S.init(M, DFF, gridDim.x, obid());
        EpiFF1 E; E.ACT = ACT;
        pg8::gemm_phase(lds, pg8::Gemm{H, (const bf16_t*)(p.ws + OFF_WFF1 + l * SZ_WFF1), M, DFF, D, D}, S, E);
        bg_convert(lds, p, 64, l, BG_C_START, BG_C_N); if (l == 0) bg_convert(lds, p, 64, 1, 0, BG_C0_EXTRA); } break;
    case 8: if (PH_MASK & 64) { gemm_residual(lds, p, ACT, (const bf16_t*)(p.ws + OFF_WFF2 + l * SZ_WFF2), DFF, (float*)(p.ws + OFF_MIX), 8, false);
        if (l == 0) bg_convert(lds, p, 128, 1, BG_F0_START, BG_F0_N); } break;
    default: if (PH_MASK & 128) { if (l == 0) phase_norm_parts(p, p.norm1_g + D, false, (const float*)(p.ws + OFF_MIX), 8, false); else phase_norm_parts(p, p.final_g, true, (const float*)(p.ws + OFF_MIX), 8, false); } break;
    }
}

struct BarState { unsigned* w; unsigned xid, cen, nx, k; };
__device__ __forceinline__ void grid_barrier(BarState& B) {
    asm volatile("s_waitcnt vmcnt(0) lgkmcnt(0)" ::: "memory");
    __syncthreads();
    if (threadIdx.x < 64) {
        if (threadIdx.x == 0) {
            const unsigned k = ++B.k;
            const unsigned o = __hip_atomic_fetch_add(B.w + 64 * (9 + B.xid), 1u, __ATOMIC_RELAXED, __HIP_MEMORY_SCOPE_AGENT) + 1u;
            if (o == k * B.cen) {
                __builtin_amdgcn_fence(__ATOMIC_RELEASE, "agent"); asm volatile("s_waitcnt vmcnt(0)" ::: "memory");
                const unsigned t = __hip_atomic_fetch_add(B.w + 64 * 17, 1u, __ATOMIC_RELAXED, __HIP_MEMORY_SCOPE_AGENT) + 1u;
                if (t == k * B.nx) __hip_atomic_store(B.w + 64 * 18, k, __ATOMIC_RELAXED, __HIP_MEMORY_SCOPE_AGENT);
            }
            while (__hip_atomic_load(B.w + 64 * 18, __ATOMIC_RELAXED, __HIP_MEMORY_SCOPE_AGENT) < k) __builtin_amdgcn_s_sleep(BAR_SLEEP);
        }
        __builtin_amdgcn_fence(__ATOMIC_ACQUIRE, "agent"); asm volatile("s_waitcnt vmcnt(0)" ::: "memory");
    }
    __syncthreads();
}
__global__ void __launch_bounds__(512, 2) mega(Params p) {
    extern __shared__ __attribute__((aligned(16))) unsigned char shm[];
    LAS unsigned char* lds = (LAS unsigned char*)shm;
    cg::grid_group grid = cg::this_grid();
    BarState B; B.w = (unsigned*)(p.ws + OFF_BAR); B.xid = (unsigned)__builtin_amdgcn_s_getreg((3 << 11) | 20) & 7u; B.cen = 0; B.nx = 0; B.k = 0;
    if (threadIdx.x == 0) __hip_atomic_fetch_add(B.w + 64 * (1 + B.xid), 1u, __ATOMIC_RELAXED, __HIP_MEMORY_SCOPE_AGENT);
    grid.sync();
    if (threadIdx.x == 0) {
        for (unsigned j = 0; j < 8; ++j) { const unsigned c = __hip_atomic_load(B.w + 64 * (1 + j), __ATOMIC_RELAXED, __HIP_MEMORY_SCOPE_AGENT); if (j == B.xid) B.cen = c; B.nx += (c != 0u) ? 1u : 0u; }
    }
    for (int i = 0; i < EXTRA_BARS; ++i) grid_barrier(B);
    for (int ph = p.ph_lo; ph < p.ph_hi; ++ph) {
        run_phase(lds, p, ph);
        if (ph + 1 < p.ph_hi) grid_barrier(B);
    }
}

extern "C" void kernel_launch(void* const* d_in, const int* in_sizes, int n_in, void* d_out, int out_size, void* d_ws, size_t ws_size, hipStream_t stream) {
    static int grid_blocks = 0;
    if (!grid_blocks) {
        int dev = 0, cus = 0, per_cu = 0;
        hipGetDevice(&dev);
        hipDeviceGetAttribute(&cus, hipDeviceAttributeMultiprocessorCount, dev);
        if (hipFuncSetAttribute((const void*)mega, hipFuncAttributeMaxDynamicSharedMemorySize, LDS_BYTES) != hipSuccess) fprintf(stderr, "hipFuncSetAttribute failed\n");
        if (hipOccupancyMaxActiveBlocksPerMultiprocessor(&per_cu, (const void*)mega, 512, LDS_BYTES) != hipSuccess || per_cu < 1) { fprintf(stderr, "occupancy query: %d\n", per_cu); per_cu = 1; }
        (void)hipGetLastError();
        if (per_cu > 1) per_cu = 1;
        grid_blocks = cus * per_cu;
        if (grid_blocks != 256) { fprintf(stderr, "this kernel's work schedule is built for 256 co-resident workgroups (one per CU of a 256-CU device); got %d; nothing launched\n", grid_blocks); grid_blocks = -1; }
        else if (ws_size < WS_END) { fprintf(stderr, "workspace too small: %zu < %zu; nothing launched\n", ws_size, (size_t)WS_END); grid_blocks = -1; }
    }
    if (grid_blocks < 0) return;
    (void)hipMemsetAsync((unsigned char*)d_ws + OFF_BAR, 0, 8192, stream);
    Params p{};
    const float** pf = (const float**)&p;
    for (int i = 0; i < 24; ++i) pf[i] = (const float*)d_in[i];
    p.out = (float*)d_out; p.ws = (unsigned char*)d_ws;
#if ONE_LAUNCH
    p.ph_lo = 0; p.ph_hi = NPH;
    { void* args[] = {&p};
      hipError_t e = hipLaunchCooperativeKernel((const void*)mega, dim3(grid_blocks), dim3(512), args, LDS_BYTES, stream);
      if (e != hipSuccess) fprintf(stderr, "cooperative launch failed: %s (grid %d)\n", hipGetErrorString(e), grid_blocks); }
#else
    for (int ph = 0; ph < NPH; ++ph) {
        p.ph_lo = ph; p.ph_hi = ph + 1;
        void* args[] = {&p};
        hipError_t e = hipLaunchCooperativeKernel((const void*)mega, dim3(grid_blocks), dim3(512), args, LDS_BYTES, stream);
        if (e != hipSuccess) { fprintf(stderr, "launch %d failed: %s (grid %d)\n", ph, hipGetErrorString(e), grid_blocks); break; }
    }
#endif
}
```

```cpp
#include <hip/hip_runtime.h>
#include <hip/hip_cooperative_groups.h>
#include <cstdio>
#include <cstdint>
namespace cg = cooperative_groups;

#ifndef ONE_LAUNCH
#define ONE_LAUNCH 1
#endif

#ifndef MIX_MASK
#define MIX_MASK 3
#endif
#ifndef EXTRA_BARS
#define EXTRA_BARS 0
#endif
#ifndef BAR_SLEEP
#define BAR_SLEEP 1
#endif
#ifndef PH_MASK
#define PH_MASK 0x1ff
#endif
#define LAS __attribute__((address_space(3)))
typedef unsigned short bf16_t;
typedef short bf16x8 __attribute__((ext_vector_type(8)));
typedef float f32x4 __attribute__((ext_vector_type(4)));
typedef unsigned u32x4 __attribute__((ext_vector_type(4)));
typedef unsigned u32x2 __attribute__((ext_vector_type(2)));

constexpr int D = 2048, M = 8704, DFF = 8192, INC = 5120, NPH = 21;
constexpr float EPS = 1e-6f;
constexpr size_t OUT_HP = 17825792, OUT_RP = 18874368, OUT_IP = 18907136, OUT_HS = 18939904, OUT_RS = 23134208, OUT_IS = 23265280;
constexpr size_t SZ_WIN = (size_t)INC * D * 2, SZ_WGLU = (size_t)1024 * 1024 * 2, SZ_WOUT = (size_t)D * D * 2, SZ_WFF1 = (size_t)DFF * D * 2, SZ_WFF2 = (size_t)D * DFF * 2;
constexpr size_t OFF_WIN = 0, OFF_WGLU = OFF_WIN + 2 * SZ_WIN, OFF_WOUT = OFF_WGLU + 2 * SZ_WGLU, OFF_WFF1 = OFF_WOUT + 2 * SZ_WOUT, OFF_WFF2 = OFF_WFF1 + 2 * SZ_WFF1;
constexpr size_t OFF_H = OFF_WFF2 + 2 * SZ_WFF2, OFF_MIX = OFF_H + (size_t)M * D * 2, OFF_HH = OFF_MIX + (size_t)M * D * 2, OFF_LB = OFF_HH + (size_t)M * 1024 * 2;
constexpr size_t OFF_R = OFF_LB + 8192;
constexpr size_t OFF_Q = OFF_R, OFF_LOGF = OFF_Q + (size_t)M * 1024 * 4, OFF_U = OFF_LOGF + (size_t)M * 1024 * 4, OFF_V = OFF_U + (size_t)M * 1024 * 4, OFF_G = OFF_V + (size_t)M * 1024 * 2;
constexpr size_t OFF_SP = OFF_H;
constexpr size_t OFF_DS = OFF_MIX;
constexpr size_t OFF_DEC = OFF_H + 33554432, OFF_S5E = OFF_DEC + 1048576;
static_assert(OFF_S5E + 1048576 <= OFF_MIX, "H tail");
constexpr size_t OFF_BAR = OFF_R + (size_t)M * DFF * 2;
constexpr size_t WS_END = OFF_BAR + 8192;
static_assert(OFF_G + (size_t)M * 1024 * 2 <= OFF_BAR, "overlay");

constexpr int LDS_BYTES = 154112;

struct Params {
    const float *x_prompt, *x_sample, *state_hgrn, *state_re, *state_im, *norm1_g, *w_in, *lb_logits, *onorm_g, *lam_re, *lam_im, *log_step,
        *B_re, *B_im, *C_re, *C_im, *s5_D, *w_glu, *b_glu, *w_out, *norm2_g, *w_ff1, *w_ff2, *final_g;
    float* out;
    unsigned char* ws;
    int ph_lo, ph_hi;
};

typedef __bf16 bf16x2_t __attribute__((ext_vector_type(2)));
__device__ __forceinline__ unsigned pk2(float lo, float hi) { bf16x2_t v; v.x = (__bf16)lo; v.y = (__bf16)hi; return __builtin_bit_cast(unsigned, v); }
__device__ __forceinline__ float bf_lo(unsigned w) { return __uint_as_float(w << 16); }
__device__ __forceinline__ float bf_hi(unsigned w) { return __uint_as_float(w & 0xffff0000u); }
__device__ __forceinline__ float sigmoidf_(float z) { return 1.0f / (1.0f + __expf(-z)); }
__device__ __forceinline__ float siluf_(float z) { return z / (1.0f + __expf(-z)); }
__device__ __forceinline__ int otid() { int t = threadIdx.x; asm volatile("" : "+v"(t)); return t; }
__device__ __forceinline__ int obid() { int t = blockIdx.x; asm volatile("" : "+s"(t)); return t; }
__device__ __forceinline__ float ld_dev_f32(const float* q) { return *q; }
__device__ __forceinline__ void st_dev_f32(float* q, float v) { *q = v; }
__device__ __forceinline__ u32x2 ld_dev_u32x2(const void* q) { return *(const u32x2*)q; }
__device__ __forceinline__ void st_dev_u32x2(void* q, u32x2 v) { *(u32x2*)q = v; }
#define MFMA_SETTLE() do { __builtin_amdgcn_sched_barrier(0); asm volatile("s_nop 15\n\ts_nop 15\n\ts_nop 15\n\ts_nop 15" ::: "memory"); __builtin_amdgcn_sched_barrier(0); } while (0)
#define LDS_FENCE() asm volatile("s_waitcnt lgkmcnt(0)" ::: "memory")

namespace pg8 {
constexpr int BM = 256, BK = 64, HALF = 128, HTB = HALF * BK * 2, STAGE_BYTES = 8 * HTB, NXCD = 8, WGM = 8;
__host__ __device__ __forceinline__ int lds_byte(int r, int c) { const int st = (r >> 4) * 2 + (c >> 5), rr = r & 15, cc = c & 31, ob = rr * 64 + cc * 2; return st * 1024 + (ob ^ (((ob >> 9) & 1) << 5)); }
__host__ __device__ __forceinline__ void stage_rc(int b, int& R, int& C) { const int st = b / 1024, sb = b % 1024, swz = sb ^ (((sb >> 9) & 1) << 5); R = (st >> 1) * 16 + swz / 64; C = (st & 1) * 32 + (swz % 64) / 2; }
__host__ __device__ __forceinline__ int perm32(int rho) { const int n = rho >> 4, i = rho & 15; return 8 * (i >> 2) + 4 * n + (i & 3); }
struct Unit { int pm, pn; };
struct Gemm { const bf16_t* A; const bf16_t* Bt; int M, N, K, LD; };
struct StaticOrder {
    int nM, nN, nwg, G, c;
    __host__ __device__ void init(int M_, int N_, int G_, int c_) { nM = M_ / BM; nN = N_ / BM; nwg = nM * nN; G = G_; c = c_; }
    __host__ __device__ bool next(int i, Unit& u) const {
        const long L = (long)i * G + c; if (L >= nwg) return false;
        int wgid = (int)L; { const int q = nwg / NXCD, r = nwg % NXCD, xcd = wgid % NXCD, off = wgid / NXCD; wgid = (xcd < r ? xcd * (q + 1) : r * (q + 1) + (xcd - r) * q) + off; }
        const int nig = WGM * nN, gid = wgid / nig, fm = gid * WGM, gsz = (nM - fm) < WGM ? (nM - fm) : WGM;
        u.pm = fm + ((wgid % nig) % gsz); u.pn = (wgid % nig) / gsz; return true;
    }
    __device__ __forceinline__ void a_ready(const Unit&) const {}
    __device__ __forceinline__ void done(const Unit&) const {}
};

struct OneUnit {
    Unit u; bool valid;
    __device__ __forceinline__ bool next(int i, Unit& o) const { if (i != 0 || !valid) return false; o = u; return true; }
    __device__ __forceinline__ void a_ready(const Unit&) const {}
    __device__ __forceinline__ void done(const Unit&) const {}
};

template <class Epi, class Sched, bool ALIGN_EPI = true, bool SP2 = true>
__device__ __forceinline__ void gemm_phase(LAS unsigned char* lds, const Gemm g, const Sched& S, const Epi& E) {
    const int tid = otid(), wid = __builtin_amdgcn_readfirstlane(tid >> 6), lane = tid & 63, wr = wid >> 2, wc = wid & 3, fr = lane & 15, fq = lane >> 4;
    const int K = g.K, LD = g.LD, nt = K / BK;
    unsigned voffA[2], voffB[2];
#pragma unroll
    for (int i = 0; i < 2; ++i) { int R, C; stage_rc(tid * 16 + i * 8192, R, C); const int Rb = Epi::PERM ? ((R & ~31) + perm32(R & 31)) : R;
        voffA[i] = (unsigned)(R * LD + C) * 2u; voffB[i] = (unsigned)(Rb * LD + C) * 2u; }
    const size_t kstep = (size_t)(BK * 2);
    const size_t hstep = (size_t)HALF * LD * 2;
    const size_t tstep = 2 * hstep;
    const unsigned ldsw = (unsigned)wid * 1024u;
    const int aoff = lds_byte(wr * 64 + fr, fq * 8), boff = lds_byte(wc * 32 + fr, fq * 8);
#define PG8_SA(b, h) (((b) * 2 + (h)) * HTB)
#define PG8_SB(b, h) ((4 + (b) * 2 + (h)) * HTB)
#define PG8_STAGE(bufoff, gbase, voff) do { _Pragma("unroll") for (int _i = 0; _i < 2; ++_i) \
        __builtin_amdgcn_global_load_lds((const unsigned*)((const char*)(gbase) + (voff)[_i]), (LAS unsigned*)(lds + (bufoff) + ldsw + _i * 8192), 16, 0, 0); } while (0)
#define PG8_LDA(dst, b, h) do { _Pragma("unroll") for (int m = 0; m < 4; ++m) _Pragma("unroll") for (int k = 0; k < 2; ++k) dst[m][k] = *(const LAS bf16x8*)(lds + PG8_SA(b, h) + aoff + m * 2048 + k * 1024); } while (0)
#define PG8_LDB(dst, b, h) do { _Pragma("unroll") for (int n = 0; n < 2; ++n) _Pragma("unroll") for (int k = 0; k < 2; ++k) dst[n][k] = *(const LAS bf16x8*)(lds + PG8_SB(b, h) + boff + n * 2048 + k * 1024); } while (0)
#define PG8_MMA(ai, bj, At, Bt) do { __builtin_amdgcn_s_setprio(1); _Pragma("unroll") for (int m = 0; m < 4; ++m) _Pragma("unroll") for (int n = 0; n < 2; ++n) _Pragma("unroll") for (int k = 0; k < 2; ++k) \
        acc[ai][bj][m][n] = __builtin_amdgcn_mfma_f32_16x16x32_bf16(Bt[n][k], At[m][k], acc[ai][bj][m][n], 0, 0, 0); __builtin_amdgcn_s_setprio(0); } while (0)
#define PG8_WAIT_V(n) asm volatile("s_waitcnt vmcnt(" #n ")" ::: "memory")
#define PG8_WAIT_L(n) asm volatile("s_waitcnt lgkmcnt(" #n ")" ::: "memory")
#define PG8_BAR __builtin_amdgcn_s_barrier()
#define PG8_SCHED __builtin_amdgcn_sched_barrier(0)
    Unit cur, nxt; int ui = 0;
    if (!S.next(0, cur)) return;
    f32x4 acc[2][2][4][2];
#pragma unroll
    for (int a = 0; a < 2; ++a)
#pragma unroll
        for (int b = 0; b < 2; ++b)
#pragma unroll
            for (int m = 0; m < 4; ++m)
#pragma unroll
                for (int n = 0; n < 2; ++n) acc[a][b][m][n] = (f32x4){0.f, 0.f, 0.f, 0.f};
    bf16x8 At[4][2], B0[2][2], B1[2][2];
    const char* cA = (const char*)g.A + (size_t)cur.pm * tstep; const char* cB = (const char*)g.Bt + (size_t)cur.pn * tstep;
    S.a_ready(cur);
    if constexpr (SP2) {
        PG8_STAGE(PG8_SB(0, 0), cB, voffB); PG8_STAGE(PG8_SB(0, 1), cB + hstep, voffB); PG8_STAGE(PG8_SA(0, 0), cA, voffA); PG8_STAGE(PG8_SA(0, 1), cA + hstep, voffA);
        if (wr == 1) PG8_BAR;
        PG8_WAIT_V(2); PG8_BAR;
        PG8_STAGE(PG8_SB(1, 0), cB + kstep, voffB); PG8_STAGE(PG8_SA(1, 0), cA + kstep, voffA); PG8_STAGE(PG8_SB(1, 1), cB + hstep + kstep, voffB);
        PG8_WAIT_V(6); PG8_BAR;
    } else {
        PG8_STAGE(PG8_SB(0, 0), cB, voffB); PG8_STAGE(PG8_SA(0, 0), cA, voffA); PG8_STAGE(PG8_SB(0, 1), cB + hstep, voffB); PG8_STAGE(PG8_SA(0, 1), cA + hstep, voffA);
        if (wr == 1) PG8_BAR;
        PG8_WAIT_V(4); PG8_BAR;
        PG8_STAGE(PG8_SB(1, 0), cB + kstep, voffB); PG8_STAGE(PG8_SA(1, 0), cA + kstep, voffA); PG8_STAGE(PG8_SB(1, 1), cB + hstep + kstep, voffB);
        PG8_WAIT_V(6); PG8_BAR;
    }
    for (;;) {
        const bool has_next = S.next(ui + 1, nxt);
        const char* nA = has_next ? (const char*)g.A + (size_t)nxt.pm * tstep : cA; const char* nB = has_next ? (const char*)g.Bt + (size_t)nxt.pn * tstep : cB;
        for (int t = 0; t < nt; t += 2) {
            const bool last = (t == nt - 2);
            const char* a1 = cA + (size_t)(t + 1) * kstep;
            const char* a2 = last ? nA : cA + (size_t)(t + 2) * kstep; const char* b2 = last ? nB : cB + (size_t)(t + 2) * kstep;
            const char* a3 = a2 + kstep; const char* b3 = b2 + kstep;
            if (last && has_next) S.a_ready(nxt);
            if constexpr (SP2) {
            PG8_LDB(B0, 0, 0); PG8_LDB(B1, 0, 1); PG8_SCHED; PG8_LDA(At, 0, 0); PG8_STAGE(PG8_SA(1, 1), a1 + hstep, voffA);
            PG8_WAIT_V(8); PG8_WAIT_L(0); PG8_BAR; PG8_MMA(0, 0, At, B0); PG8_MMA(0, 1, At, B1); PG8_BAR; PG8_SCHED;
            PG8_LDA(At, 0, 1); PG8_STAGE(PG8_SB(0, 0), b2, voffB); PG8_STAGE(PG8_SB(0, 1), b2 + hstep, voffB); PG8_STAGE(PG8_SA(0, 0), a2, voffA);
            PG8_WAIT_V(8); PG8_WAIT_L(0); PG8_BAR; PG8_MMA(1, 0, At, B0); PG8_MMA(1, 1, At, B1); PG8_BAR; PG8_SCHED;
            PG8_LDB(B0, 1, 0); PG8_LDB(B1, 1, 1); PG8_SCHED; PG8_LDA(At, 1, 0); PG8_STAGE(PG8_SA(0, 1), a2 + hstep, voffA);
            PG8_WAIT_V(8); PG8_WAIT_L(0); PG8_BAR; PG8_MMA(0, 0, At, B0); PG8_MMA(0, 1, At, B1); PG8_BAR; PG8_SCHED;
            PG8_LDA(At, 1, 1); PG8_STAGE(PG8_SB(1, 0), b3, voffB); PG8_STAGE(PG8_SB(1, 1), b3 + hstep, voffB); PG8_STAGE(PG8_SA(1, 0), a3, voffA);
            PG8_WAIT_V(8); PG8_WAIT_L(0); PG8_BAR; PG8_MMA(1, 0, At, B0); PG8_MMA(1, 1, At, B1); PG8_BAR; PG8_SCHED;
            } else {
            PG8_LDB(B0, 0, 0); PG8_SCHED; PG8_LDA(At, 0, 0); PG8_STAGE(PG8_SA(1, 1), a1 + hstep, voffA);
            PG8_WAIT_L(8); PG8_BAR; PG8_WAIT_L(0); PG8_MMA(0, 0, At, B0); PG8_BAR; PG8_SCHED;
            PG8_LDB(B1, 0, 1); PG8_STAGE(PG8_SB(0, 0), b2, voffB);
            PG8_BAR; PG8_WAIT_L(0); PG8_MMA(0, 1, At, B1); PG8_BAR;
            PG8_LDA(At, 0, 1); PG8_STAGE(PG8_SA(0, 0), a2, voffA);
            PG8_BAR; PG8_WAIT_L(0); PG8_MMA(1, 0, At, B0); PG8_BAR; PG8_SCHED;
            PG8_STAGE(PG8_SB(0, 1), b2 + hstep, voffB);
            PG8_WAIT_V(6); PG8_BAR; PG8_MMA(1, 1, At, B1); PG8_BAR;
            PG8_LDB(B0, 1, 0); PG8_SCHED; PG8_LDA(At, 1, 0); PG8_STAGE(PG8_SA(0, 1), a2 + hstep, voffA);
            PG8_WAIT_L(8); PG8_BAR; PG8_WAIT_L(0); PG8_MMA(0, 0, At, B0); PG8_BAR; PG8_SCHED;
            PG8_LDB(B1, 1, 1); PG8_STAGE(PG8_SB(1, 0), b3, voffB);
            PG8_BAR; PG8_WAIT_L(0); PG8_MMA(0, 1, At, B1); PG8_BAR;
            PG8_LDA(At, 1, 1); PG8_STAGE(PG8_SA(1, 0), a3, voffA);
            PG8_BAR; PG8_WAIT_L(0); PG8_MMA(1, 0, At, B0); PG8_BAR; PG8_SCHED;
            PG8_STAGE(PG8_SB(1, 1), b3 + hstep, voffB);
            PG8_WAIT_V(6); PG8_BAR; PG8_MMA(1, 1, At, B1); PG8_BAR;
            }
        }
        if constexpr (ALIGN_EPI) { if (wr == 0) PG8_BAR; }
        MFMA_SETTLE();
        E(acc, cur, wr, wc, fr, fq); S.done(cur);
        if (!has_next) break;
#pragma unroll
        for (int a = 0; a < 2; ++a)
#pragma unroll
            for (int b = 0; b < 2; ++b)
#pragma unroll
                for (int m = 0; m < 4; ++m)
#pragma unroll
                    for (int n = 0; n < 2; ++n) acc[a][b][m][n] = (f32x4){0.f, 0.f, 0.f, 0.f};
        cur = nxt; cA = nA; cB = nB; ++ui;
        if constexpr (ALIGN_EPI) { if (wr == 1) PG8_BAR; }
    }
    PG8_WAIT_V(0);
    if constexpr (!ALIGN_EPI) { if (wr == 0) PG8_BAR; }
    PG8_BAR;
#undef PG8_SA
#undef PG8_SB
#undef PG8_STAGE
#undef PG8_LDA
#undef PG8_LDB
#undef PG8_MMA
#undef PG8_WAIT_V
#undef PG8_WAIT_L
#undef PG8_BAR
#undef PG8_SCHED
}
}

typedef f32x4 AccT[2][2][4][2];

struct EpiIn {
    static constexpr bool PERM = true;
    float *Q, *LOGF, *U; bf16_t *V, *G; const float* LB;
    __device__ __forceinline__ void operator()(const AccT& acc, const pg8::Unit& u, int wr, int wc, int fr, int fq) const {
        const int row0 = u.pm * 256 + wr * 64 + fr, sect = u.pn >> 2, colb = (u.pn & 3) * 256 + wc * 32 + 8 * fq;
        if (false) {
        } else if (sect == 1) {
            f32x4 lb[2][2];
#pragma unroll
            for (int bj = 0; bj < 2; ++bj)
#pragma unroll
                for (int n = 0; n < 2; ++n) lb[bj][n] = *(const f32x4*)(LB + colb + bj * 128 + n * 4);
#pragma unroll
            for (int ai = 0; ai < 2; ++ai)
#pragma unroll
                for (int m = 0; m < 4; ++m) { float* rp = LOGF + (size_t)(row0 + ai * 128 + m * 16) * 1024 + colb;
#pragma unroll
                    for (int bj = 0; bj < 2; ++bj)
#pragma unroll
                        for (int n = 0; n < 2; ++n) { f32x4 v = acc[ai][bj][m][n], o;
#pragma unroll
                            for (int j = 0; j < 4; ++j) { const float l_ = lb[bj][n][j]; const float f = l_ + (1.0f - l_) * sigmoidf_(v[j]); o[j] = logf(f); }
                            *(f32x4*)(rp + bj * 128 + n * 4) = o; } }
        } else {
            bf16_t* dst = sect == 0 ? (bf16_t*)Q : sect == 2 ? V : sect == 3 ? G : (bf16_t*)U;
#pragma unroll
            for (int ai = 0; ai < 2; ++ai)
#pragma unroll
                for (int m = 0; m < 4; ++m) { bf16_t* rp = dst + (size_t)(row0 + ai * 128 + m * 16) * 1024 + colb;
#pragma unroll
                    for (int bj = 0; bj < 2; ++bj) { f32x4 v0 = acc[ai][bj][m][0], v1 = acc[ai][bj][m][1];
                        if (sect == 0 || sect == 3) {
#pragma unroll
                            for (int j = 0; j < 4; ++j) { v0[j] = siluf_(v0[j]); v1[j] = siluf_(v1[j]); } }
                        u32x4 w; w.x = pk2(v0[0], v0[1]); w.y = pk2(v0[2], v0[3]); w.z = pk2(v1[0], v1[1]); w.w = pk2(v1[2], v1[3]);
                        *(u32x4*)(rp + bj * 128) = w; } }
        }
    }
};
struct EpiGlu {
    static constexpr bool PERM = true;
    bf16_t* MIX; const bf16_t* HH; const float* bias;
    __device__ __forceinline__ void operator()(const AccT& acc, const pg8::Unit& u, int wr, int wc, int fr, int fq) const {
        const int row0 = u.pm * 256 + wr * 64 + fr, colb = u.pn * 256 + wc * 32 + 8 * fq;
        f32x4 bv[2][2];
#pragma unroll
        for (int bj = 0; bj < 2; ++bj)
#pragma unroll
            for (int n = 0; n < 2; ++n) bv[bj][n] = *(const f32x4*)(bias + colb + bj * 128 + n * 4);
#pragma unroll
        for (int ai = 0; ai < 2; ++ai)
#pragma unroll
            for (int m = 0; m < 4; ++m) { const size_t r = (size_t)(row0 + ai * 128 + m * 16);
#pragma unroll
                for (int bj = 0; bj < 2; ++bj) { const u32x4 hw = *(const u32x4*)(HH + r * 1024 + colb + bj * 128);
                    const f32x4 v0 = acc[ai][bj][m][0] + bv[bj][0], v1 = acc[ai][bj][m][1] + bv[bj][1];
                    u32x4 w;
                    w.x = pk2(bf_lo(hw.x) * sigmoidf_(v0[0]), bf_hi(hw.x) * sigmoidf_(v0[1])); w.y = pk2(bf_lo(hw.y) * sigmoidf_(v0[2]), bf_hi(hw.y) * sigmoidf_(v0[3]));
                    w.z = pk2(bf_lo(hw.z) * sigmoidf_(v1[0]), bf_hi(hw.z) * sigmoidf_(v1[1])); w.w = pk2(bf_lo(hw.w) * sigmoidf_(v1[2]), bf_hi(hw.w) * sigmoidf_(v1[3]));
                    *(u32x4*)(MIX + r * 2048 + 1024 + colb + bj * 128) = w; } }
    }
};
struct EpiRes {
    static constexpr bool PERM = true;
    float* X;
    __device__ __forceinline__ void operator()(const AccT& acc, const pg8::Unit& u, int wr, int wc, int fr, int fq) const {
        const int row0 = u.pm * 256 + wr * 64 + fr, colb = u.pn * 256 + wc * 32 + 8 * fq;
#pragma unroll
        for (int ai = 0; ai < 2; ++ai)
#pragma unroll
            for (int m = 0; m < 4; ++m) { float* rp = X + (size_t)(row0 + ai * 128 + m * 16) * 2048 + colb;
#pragma unroll
                for (int bj = 0; bj < 2; ++bj)
#pragma unroll
                    for (int n = 0; n < 2; ++n) { f32x4* pp = (f32x4*)(rp + bj * 128 + n * 4); *pp = *pp + acc[ai][bj][m][n]; } }
    }
};
struct EpiPart {
    static constexpr bool PERM = true;
    float* P;
    __device__ __forceinline__ void operator()(const AccT& acc, const pg8::Unit& u, int wr, int wc, int fr, int fq) const {
        const int row0 = wr * 64 + fr, colb = wc * 32 + 8 * fq;
#pragma unroll
        for (int ai = 0; ai < 2; ++ai)
#pragma unroll
            for (int m = 0; m < 4; ++m) { float* rp = P + (size_t)(row0 + ai * 128 + m * 16) * 256 + colb;
#pragma unroll
                for (int bj = 0; bj < 2; ++bj)
#pragma unroll
                    for (int n = 0; n < 2; ++n) *(f32x4*)(rp + bj * 128 + n * 4) = acc[ai][bj][m][n]; }
    }
};
struct EpiFF1 {
    static constexpr bool PERM = true;
    bf16_t* ACT;
    __device__ __forceinline__ void operator()(const AccT& acc, const pg8::Unit& u, int wr, int wc, int fr, int fq) const {
        const int row0 = u.pm * 256 + wr * 64 + fr, colb = u.pn * 256 + wc * 32 + 8 * fq;
#pragma unroll
        for (int ai = 0; ai < 2; ++ai)
#pragma unroll
            for (int m = 0; m < 4; ++m) { bf16_t* rp = ACT + (size_t)(row0 + ai * 128 + m * 16) * 8192 + colb;
#pragma unroll
                for (int bj = 0; bj < 2; ++bj) { f32x4 v0 = acc[ai][bj][m][0], v1 = acc[ai][bj][m][1];
#pragma unroll
                    for (int j = 0; j < 4; ++j) { const float a = fmaxf(v0[j], 0.f), b = fmaxf(v1[j], 0.f); v0[j] = a * a; v1[j] = b * b; }
                    u32x4 w; w.x = pk2(v0[0], v0[1]); w.y = pk2(v0[2], v0[3]); w.z = pk2(v1[0], v1[1]); w.w = pk2(v1[2], v1[3]);
                    *(u32x4*)(rp + bj * 128) = w; } }
    }
};

__device__ __forceinline__ float wave_sum(float v) {
#pragma unroll
    for (int o = 1; o < 64; o <<= 1) v += __shfl_xor(v, o);
    return v;
}
__device__ __forceinline__ void rms_row(const float* xrow, const float* g, float* copy_dst, bf16_t* hrow, float* yrow, int lane) {
    f32x4 v[8]; float s = 0.f;
#pragma unroll
    for (int j = 0; j < 8; ++j) { v[j] = *((const f32x4*)xrow + lane + 64 * j); s += (v[j][0] * v[j][0] + v[j][1] * v[j][1]) + (v[j][2] * v[j][2] + v[j][3] * v[j][3]); }
    const float rstd = 1.0f / sqrtf(wave_sum(s) * (1.0f / 2048.0f) + EPS);
#pragma unroll
    for (int j = 0; j < 8; ++j) {
        const f32x4 gg = *((const f32x4*)g + lane + 64 * j);
        if (copy_dst) *((f32x4*)copy_dst + lane + 64 * j) = v[j];
        const f32x4 o = v[j] * rstd * gg;
        if (hrow) { u32x2 w; w.x = pk2(o[0], o[1]); w.y = pk2(o[2], o[3]); *((u32x2*)hrow + lane + 64 * j) = w; }
        if (yrow) *((f32x4*)yrow + lane + 64 * j) = o;
    }
}
__device__ __forceinline__ void transpose_item(const float* W, int K, int N, bf16_t* WT, LAS float* scr, int item, int lane) {
    const int nblk = N / 32, kb = item / nblk, nb = item % nblk, k0 = 64 * kb, n0 = 32 * nb;
    {
        f32x4 t[8];
#pragma unroll
        for (int i = 0; i < 8; ++i) t[i] = *(const f32x4*)(W + (size_t)(k0 + 8 * i + (lane >> 3)) * N + n0 + 4 * (lane & 7));
#pragma unroll
        for (int i = 0; i < 8; ++i) { LAS float* d = scr + (8 * i + (lane >> 3)) * 33 + 4 * (lane & 7); d[0] = t[i][0]; d[1] = t[i][1]; d[2] = t[i][2]; d[3] = t[i][3]; }
    }
    LDS_FENCE();
    const int c = lane & 7;
#pragma unroll
    for (int j = 0; j < 4; ++j) { const int n = (lane >> 3) + 8 * j; const LAS float* s = scr + (8 * c) * 33 + n;
        u32x4 o; o.x = pk2(s[0 * 33], s[1 * 33]); o.y = pk2(s[2 * 33], s[3 * 33]); o.z = pk2(s[4 * 33], s[5 * 33]); o.w = pk2(s[6 * 33], s[7 * 33]);
        *(u32x4*)(WT + (size_t)(n0 + n) * K + k0 + 8 * c) = o; }
    LDS_FENCE();
}
constexpr int I_IN = 32 * 160, I_GLU = 16 * 32, I_OUT = 32 * 64, I_F1 = 32 * 256, I_F2 = 128 * 64, I_L = I_IN + I_GLU + I_OUT + I_F1 + I_F2;
__device__ __forceinline__ void conv_item(const Params& p, LAS float* scr, int l, int r, int lane) {
    if (r < I_IN) { transpose_item(p.w_in + (size_t)l * D * INC, D, INC, (bf16_t*)(p.ws + OFF_WIN + l * SZ_WIN), scr, r, lane); return; } r -= I_IN;
    if (r < I_GLU) { transpose_item(p.w_glu + (size_t)l * 1024 * 1024, 1024, 1024, (bf16_t*)(p.ws + OFF_WGLU + l * SZ_WGLU), scr, r, lane); return; } r -= I_GLU;
    if (r < I_OUT) { transpose_item(p.w_out + (size_t)l * D * D, D, D, (bf16_t*)(p.ws + OFF_WOUT + l * SZ_WOUT), scr, r, lane); return; } r -= I_OUT;
    if (r < I_F1) { transpose_item(p.w_ff1 + (size_t)l * D * DFF, D, DFF, (bf16_t*)(p.ws + OFF_WFF1 + l * SZ_WFF1), scr, r, lane); return; } r -= I_F1;
    transpose_item(p.w_ff2 + (size_t)l * DFF * D, DFF, D, (bf16_t*)(p.ws + OFF_WFF2 + l * SZ_WFF2), scr, r, lane);
}
__device__ __forceinline__ void bg_convert(LAS unsigned char* lds, const Params& p, int first_idle, int l, int start, int count) {
    if (gridDim.x != 256) return;
    const int bid = obid(); if (bid < first_idle) return;
    const int tid = otid(), lane = tid & 63, w = tid >> 6;
    LAS float* scr = (LAS float*)(lds + w * 8448);
    const int nw = (256 - first_idle) * 8;
    for (int i = (bid - first_idle) * 8 + w; i < count; i += nw) conv_item(p, scr, l, start + i, lane);
}
constexpr int BG_A_START = 5632, BG_A_N = 4224, BG_B_START = 9856, BG_B_N = 3840, BG_O_START = 13696, BG_O_N = 1536, BG_P0_START = 15232, BG_P0_N = 640, BG_C_START = 15872, BG_C_N = 8192;
constexpr int BG_C0_EXTRA = 2560, BG_F0_START = 2560, BG_F0_N = 3072;
static_assert(BG_A_START + BG_A_N == BG_B_START && BG_B_START + BG_B_N == BG_O_START && BG_O_START + BG_O_N == BG_P0_START && BG_P0_START + BG_P0_N == BG_C_START && BG_C_START + BG_C_N == I_L, "schedule covers the layer");
static_assert(BG_C0_EXTRA == BG_F0_START && BG_F0_START + BG_F0_N == BG_A_START, "schedule covers layer 1's first matrices");
__device__ __forceinline__ void phase0(LAS unsigned char* lds, const Params& p) {
    const int tid = otid(), lane = tid & 63, w = tid >> 6;
    const int gw = obid() * 8 + w, NGW = gridDim.x * 8;
    LAS float* scr = (LAS float*)(lds + w * 8448);
    if (gridDim.x == 256) {
        for (int it = gw; it < BG_A_START + 2 * BG_P0_N; it += NGW) {
            if (it < BG_A_START) conv_item(p, scr, 0, it, lane);
            else if (it < BG_A_START + BG_P0_N) conv_item(p, scr, 0, BG_P0_START + (it - BG_A_START), lane);
            else conv_item(p, scr, 1, BG_P0_START + (it - BG_A_START - BG_P0_N), lane);
        }
    }
    bf16_t* H = (bf16_t*)(p.ws + OFF_H);
    for (int r = gw; r < M; r += NGW) {
        const float* src = r < 8192 ? p.x_prompt + (size_t)r * D : p.x_sample + (size_t)(r - 8192) * D;
        rms_row(src, p.norm1_g, p.out + (size_t)r * D, H + (size_t)r * D, nullptr, lane);
    }
    if (obid() == 0) {
        float* LB = (float*)(p.ws + OFF_LB);
        for (int c = tid; c < 1024; c += 512) { const float l0 = p.lb_logits[c], l1 = p.lb_logits[1024 + c]; LB[c] = 0.f; LB[1024 + c] = 1.0f / (1.0f + expf(l0 - l1)); }
    }
}
__device__ __forceinline__ void phase_norm_parts(const Params& p, const float* g, bool final_, const float* part, int splits) {
    const int tid_ = otid(); const int lane = tid_ & 63, w = tid_ >> 6;
    bf16_t* H = (bf16_t*)(p.ws + OFF_H);
    const int G = gridDim.x;
    for (int r = obid() * 8 + w; r < M; r += G * 8) {
        float* xr = p.out + (size_t)r * D;
        const int pm = r >> 8;
        unsigned long long code = 0ull;
        if (G == 256) { for (int j = 0; j < 16; ++j) { pg8::StaticOrder T; T.init(M, D, G, j); pg8::Unit u; T.next(1, u); if (u.pm == pm) code |= (unsigned long long)(j + 1) << (8 * u.pn); } }
        f32x4 v[8]; float s = 0.f;
#pragma unroll
        for (int j = 0; j < 8; ++j) {
            v[j] = *((const f32x4*)xr + lane + 64 * j);
            const int lj = (int)((code >> (8 * j)) & 0xffull);
            if (lj) { const float* pp = part + (size_t)(lj - 1) * splits * 65536 + (size_t)(r & 255) * 256 + 4 * lane;
                for (int ks = 0; ks < splits; ++ks) v[j] = v[j] + *(const f32x4*)(pp + (size_t)ks * 65536);
                if (!final_) *((f32x4*)xr + lane + 64 * j) = v[j]; }
            s += (v[j][0] * v[j][0] + v[j][1] * v[j][1]) + (v[j][2] * v[j][2] + v[j][3] * v[j][3]);
        }
        const float rstd = 1.0f / sqrtf(wave_sum(s) * (1.0f / 2048.0f) + EPS);
#pragma unroll
        for (int j = 0; j < 8; ++j) {
            const f32x4 gg = *((const f32x4*)g + lane + 64 * j);
            const f32x4 o = v[j] * rstd * gg;
            if (final_) *((f32x4*)xr + lane + 64 * j) = o;
            else { u32x2 wv; wv.x = pk2(o[0], o[1]); wv.y = pk2(o[2], o[3]); *((u32x2*)(H + (size_t)r * D) + lane + 64 * j) = wv; }
        }
    }
}
__device__ __forceinline__ void phase_norm(const Params& p, const float* g, bool final_) {
    const int tid_ = otid(); const int lane = tid_ & 63, w = tid_ >> 6;
    bf16_t* H = (bf16_t*)(p.ws + OFF_H);
    for (int r = obid() * 8 + w; r < M; r += gridDim.x * 8) {
        float* xr = p.out + (size_t)r * D;
        if (final_) rms_row(xr, g, nullptr, nullptr, xr, lane); else rms_row(xr, g, nullptr, H + (size_t)r * D, nullptr, lane);
    }
}

constexpr int H_QT = 0, H_KT = 17408, H_ATT = 34816, H_VT = 44032, H_ST = 62464, H_KHT = 97280, H_CUM = 115712, H_SEG = 149504, H_SSQ = 153600;
#define MFMA16(a, b, c) __builtin_amdgcn_mfma_f32_16x16x32_bf16(a, b, c, 0, 0, 0)
#define FRAG(off) (*(const LAS bf16x8*)(lds + (off)))
struct HItem { int b, h, nvalid, rbase, pidx; };
__device__ __forceinline__ HItem hgrn_decode(int item) {
    HItem r;
    if (item < 1024) { const int bh = item >> 5, c = item & 31; r.b = bh >> 3; r.h = bh & 7; r.nvalid = 64; r.rbase = r.b * 2048 + c * 64; r.pidx = item; }
    else { const int j = item - 1024; r.b = j >> 3; r.h = j & 7; r.nvalid = 32; r.rbase = 8192 + r.b * 32; r.pidx = -1; }
    return r;
}
__device__ __forceinline__ void hgrn_load_vt(LAS unsigned char* lds, const bf16_t* Vp, int rbase, int nvalid, int tid) {
    const int s2 = (tid & 31) * 2, c0 = (tid >> 5) * 8;
    u32x4 a = (u32x4){0u, 0u, 0u, 0u}, b = a;
    if (s2 < nvalid) a = *(const u32x4*)(Vp + (size_t)(rbase + s2) * 1024 + c0);
    if (s2 + 1 < nvalid) b = *(const u32x4*)(Vp + (size_t)(rbase + s2 + 1) * 1024 + c0);
    LAS unsigned* vt = (LAS unsigned*)(lds + H_VT + c0 * 144 + s2 * 2);
#pragma unroll
    for (int j = 0; j < 4; ++j) {
        vt[(2 * j) * 36] = (a[j] & 0xffffu) | (b[j] << 16);
        vt[(2 * j + 1) * 36] = (a[j] >> 16) | (b[j] & 0xffff0000u);
    }
}
__device__ __forceinline__ void hgrn_m1_item(LAS unsigned char* lds, const Params& p, int l, int item) {
    const int tid = otid(), lane = tid & 63, w = tid >> 6, q4 = lane >> 4, l15 = lane & 15;
    const HItem I = hgrn_decode(item);
    const float* LFp = (const float*)(p.ws + OFF_LOGF) + I.h * 128;
    const bf16_t* Vp = (const bf16_t*)(p.ws + OFF_V) + I.h * 128;
    LAS float* SEGf = (LAS float*)(lds + H_SEG);
    {
        const int kcol = tid & 127, seg = tid >> 7;
        float lf[16], c[16];
#pragma unroll
        for (int i = 0; i < 16; ++i) { const int t = seg * 16 + i; lf[i] = (t < I.nvalid) ? LFp[(size_t)(I.rbase + t) * 1024 + kcol] : 0.f; }
        hgrn_load_vt(lds, Vp, I.rbase, I.nvalid, tid);
        c[0] = lf[0];
#pragma unroll
        for (int i = 1; i < 16; ++i) c[i] = c[i - 1] + lf[i];
        SEGf[seg * 128 + kcol] = c[15];
        __syncthreads();
        const float s0 = SEGf[kcol], s1 = SEGf[128 + kcol], s2 = SEGf[256 + kcol], s3 = SEGf[384 + kcol];
        const float off = (seg > 0 ? s0 : 0.f) + (seg > 1 ? s1 : 0.f) + (seg > 2 ? s2 : 0.f);
        const float last = (s0 + s1) + (s2 + s3), ref = s0 + s1;
        if (seg == 0) {
            const float el = __expf(last);
            SEGf[768 + kcol] = el;
            if (I.pidx >= 0) { float* dec = (float*)(p.ws + OFF_DEC) + (size_t)I.pidx * 256; st_dev_f32(dec + kcol, el); st_dev_f32(dec + 128 + kcol, __expf(ref)); }
        }
        unsigned pk[8];
#pragma unroll
        for (int i = 0; i < 16; i += 2) {
            const float c0 = off + c[i], c1 = off + c[i + 1];
            const float k0 = (1.0f - __expf(lf[i])) * __expf(last - c0), k1 = (1.0f - __expf(lf[i + 1])) * __expf(last - c1);
            pk[i >> 1] = pk2(k0, k1);
        }
        LAS u32x4* kd = (LAS u32x4*)(lds + H_KHT + kcol * 144 + seg * 32);
        kd[0] = (u32x4){pk[0], pk[1], pk[2], pk[3]}; kd[1] = (u32x4){pk[4], pk[5], pk[6], pk[7]};
    }
    __syncthreads();
    {
        bf16x8 ka[2];
#pragma unroll
        for (int ks = 0; ks < 2; ++ks) ka[ks] = FRAG(H_KHT + (16 * w + l15) * 144 + (32 * ks + 8 * q4) * 2);
        if (I.pidx >= 0) {
            bf16_t* ds = (bf16_t*)(p.ws + OFF_DS) + (size_t)I.pidx * 16384;
#pragma unroll
            for (int vt = 0; vt < 8; ++vt) { f32x4 s = (f32x4){0.f, 0.f, 0.f, 0.f};
#pragma unroll
                for (int ks = 0; ks < 2; ++ks) { const bf16x8 bv = FRAG(H_VT + (16 * vt + l15) * 144 + (32 * ks + 8 * q4) * 2); s = MFMA16(ka[ks], bv, s); }
                MFMA_SETTLE();
                u32x2 o; o.x = pk2(s[0], s[1]); o.y = pk2(s[2], s[3]);
                st_dev_u32x2(ds + (16 * vt + l15) * 128 + 16 * w + 4 * q4, o); }
        } else {
            const f32x4 el = *(const LAS f32x4*)(lds + H_SEG + 3072 + (16 * w + 4 * q4) * 4);
            const float* sin_ = p.state_hgrn + ((size_t)(l * 16 + I.b) * 8 + I.h) * 16384;
            float* sout = p.out + OUT_HS + ((size_t)(l * 16 + I.b) * 8 + I.h) * 16384;
#pragma unroll
            for (int vt = 0; vt < 8; ++vt) { f32x4 s;
#pragma unroll
                for (int j = 0; j < 4; ++j) s[j] = sin_[(16 * w + 4 * q4 + j) * 128 + 16 * vt + l15] * el[j];
#pragma unroll
                for (int ks = 0; ks < 2; ++ks) { const bf16x8 bv = FRAG(H_VT + (16 * vt + l15) * 144 + (32 * ks + 8 * q4) * 2); s = MFMA16(ka[ks], bv, s); }
                MFMA_SETTLE();
#pragma unroll
                for (int j = 0; j < 4; ++j) sout[(16 * w + 4 * q4 + j) * 128 + 16 * vt + l15] = s[j]; }
        }
    }
    __syncthreads();
}
__device__ __forceinline__ void hgrn_m2(const Params& p, int l) {
    const int gt = obid() * 512 + otid(), GT = gridDim.x * 512;
    for (int idx = gt; idx < 32 * 128 * 32; idx += GT) {
        const int bh = idx >> 12, v = (idx >> 5) & 127, k4 = (idx & 31) * 4;
        const bf16_t* ds = (const bf16_t*)(p.ws + OFF_DS) + (size_t)bh * 32 * 16384 + v * 128 + k4;
        const float* dec = (const float*)(p.ws + OFF_DEC) + (size_t)bh * 32 * 256 + k4;
        bf16_t* sp = (bf16_t*)(p.ws + OFF_SP) + (size_t)bh * 32 * 16384 + v * 128 + k4;
        f32x4 S = (f32x4){0.f, 0.f, 0.f, 0.f};
#pragma unroll 8
        for (int c = 0; c < 32; ++c) {
            const u32x2 e0_ = ld_dev_u32x2(dec + c * 256), e1_ = ld_dev_u32x2(dec + c * 256 + 2), r0_ = ld_dev_u32x2(dec + c * 256 + 128), r1_ = ld_dev_u32x2(dec + c * 256 + 130);
            const f32x4 el = (f32x4){__uint_as_float(e0_.x), __uint_as_float(e0_.y), __uint_as_float(e1_.x), __uint_as_float(e1_.y)}, er = (f32x4){__uint_as_float(r0_.x), __uint_as_float(r0_.y), __uint_as_float(r1_.x), __uint_as_float(r1_.y)};
            const u32x2 dw = ld_dev_u32x2(ds + (size_t)c * 16384);
            const f32x4 d4 = (f32x4){bf_lo(dw.x), bf_hi(dw.x), bf_lo(dw.y), bf_hi(dw.y)};
            u32x2 o; o.x = pk2(S[0] * er[0], S[1] * er[1]); o.y = pk2(S[2] * er[2], S[3] * er[3]);
            st_dev_u32x2(sp + (size_t)c * 16384, o);
            S = S * el + d4;
        }
        float* so = p.out + OUT_HP + ((size_t)(l * 32 + bh)) * 16384;
#pragma unroll
        for (int j = 0; j < 4; ++j) so[(k4 + j) * 128 + v] = S[j];
    }
}
__device__ __forceinline__ void hgrn_m3_item(LAS unsigned char* lds, const Params& p, int l, int item) {
    const int tid = otid(), lane = tid & 63, w = tid >> 6, q4 = lane >> 4, l15 = lane & 15;
    const HItem I = hgrn_decode(item);
    const bf16_t* Qp = (const bf16_t*)(p.ws + OFF_Q) + I.h * 128; const float* LFp = (const float*)(p.ws + OFF_LOGF) + I.h * 128;
    const bf16_t* Vp = (const bf16_t*)(p.ws + OFF_V) + I.h * 128; const bf16_t* Gp = (const bf16_t*)(p.ws + OFF_G) + I.h * 128;
    bf16_t* MIXp = (bf16_t*)(p.ws + OFF_MIX) + I.h * 128;
    const float* og = p.onorm_g + l * 1024 + I.h * 128;
    LAS float* SEGf = (LAS float*)(lds + H_SEG); LAS float* CUMf = (LAS float*)(lds + H_CUM); LAS float* SSQf = (LAS float*)(lds + H_SSQ);
    const int rbase = I.rbase, nvalid = I.nvalid;
    const int tB = tid >> 3, k0B = (tid & 7) * 16; const bool validB = tB < nvalid;
    f32x4 qv[4], lv[4];
#pragma unroll
    for (int i = 0; i < 4; ++i) { qv[i] = (f32x4){0.f, 0.f, 0.f, 0.f}; lv[i] = qv[i];
        if (validB) { const u32x2 qw = *(const u32x2*)(Qp + (size_t)(rbase + tB) * 1024 + k0B + 4 * i); qv[i] = (f32x4){bf_lo(qw.x), bf_hi(qw.x), bf_lo(qw.y), bf_hi(qw.y)};
            lv[i] = *(const f32x4*)(LFp + (size_t)(rbase + tB) * 1024 + k0B + 4 * i); } }
    u32x4 spv[4];
    {
        const bool zero = (I.pidx < 0) || ((I.pidx & 31) == 0);
        const char* sp = (const char*)((const bf16_t*)(p.ws + OFF_SP) + (size_t)(I.pidx < 0 ? 0 : I.pidx) * 16384);
#pragma unroll
        for (int i = 0; i < 4; ++i) { const int id = tid + 512 * i; spv[i] = (u32x4){0u, 0u, 0u, 0u};
            if (!zero) spv[i] = *(const u32x4*)(sp + (size_t)id * 16); }
    }
    {
        const int kcol = tid & 127, seg = tid >> 7;
        float c[16];
#pragma unroll
        for (int i = 0; i < 16; ++i) { const int t = seg * 16 + i; c[i] = (t < nvalid) ? LFp[(size_t)(rbase + t) * 1024 + kcol] : 0.f; }
        hgrn_load_vt(lds, Vp, rbase, nvalid, tid);
#pragma unroll
        for (int i = 1; i < 16; ++i) c[i] = c[i - 1] + c[i];
        SEGf[seg * 128 + kcol] = c[15];
        __syncthreads();
        const float s0 = SEGf[kcol], s1 = SEGf[128 + kcol], s2 = SEGf[256 + kcol];
        const float off = (seg > 0 ? s0 : 0.f) + (seg > 1 ? s1 : 0.f) + (seg > 2 ? s2 : 0.f);
        const float ref = s0 + s1;
        if (seg == 0) { SEGf[512 + kcol] = ref; SEGf[640 + kcol] = __expf(ref); }
#pragma unroll
        for (int i = 0; i < 16; ++i) CUMf[(seg * 16 + i) * 132 + kcol] = off + c[i];
    }
    __syncthreads();
    {
        unsigned qpk[8], kpk[8];
#pragma unroll
        for (int i = 0; i < 4; ++i) {
            const f32x4 cu = *(const LAS f32x4*)(lds + H_CUM + (tB * 132 + k0B + 4 * i) * 4), rf = *(const LAS f32x4*)(lds + H_SEG + 2048 + (k0B + 4 * i) * 4);
            float qt[4], kt[4];
#pragma unroll
            for (int j = 0; j < 4; ++j) { const float d = cu[j] - rf[j]; qt[j] = qv[i][j] * __expf(d); kt[j] = (1.0f - __expf(lv[i][j])) * __expf(-d); }
            qpk[2 * i] = pk2(qt[0], qt[1]); qpk[2 * i + 1] = pk2(qt[2], qt[3]); kpk[2 * i] = pk2(kt[0], kt[1]); kpk[2 * i + 1] = pk2(kt[2], kt[3]);
        }
        LAS u32x4* qd = (LAS u32x4*)(lds + H_QT + tB * 272 + k0B * 2); qd[0] = (u32x4){qpk[0], qpk[1], qpk[2], qpk[3]}; qd[1] = (u32x4){qpk[4], qpk[5], qpk[6], qpk[7]};
        LAS u32x4* kd = (LAS u32x4*)(lds + H_KT + tB * 272 + k0B * 2); kd[0] = (u32x4){kpk[0], kpk[1], kpk[2], kpk[3]}; kd[1] = (u32x4){kpk[4], kpk[5], kpk[6], kpk[7]};
    }
    if (I.pidx >= 0) {
#pragma unroll
        for (int i = 0; i < 4; ++i) { const int id = tid + 512 * i, row = id >> 4, c16 = id & 15; *(LAS u32x4*)(lds + H_ST + row * 272 + c16 * 16) = spv[i]; }
    } else {
        const float* sin_ = p.state_hgrn + ((size_t)(l * 16 + I.b) * 8 + I.h) * 16384;
        const f32x4 er = *(const LAS f32x4*)(lds + H_SEG + 2560 + (16 * w + 4 * q4) * 4);
#pragma unroll
        for (int vt = 0; vt < 8; ++vt) { float s[4];
#pragma unroll
            for (int j = 0; j < 4; ++j) s[j] = sin_[(16 * w + 4 * q4 + j) * 128 + 16 * vt + l15] * er[j];
            u32x2 o; o.x = pk2(s[0], s[1]); o.y = pk2(s[2], s[3]);
            *(LAS u32x2*)(lds + H_ST + (16 * vt + l15) * 272 + (16 * w + 4 * q4) * 2) = o; }
    }
    __syncthreads();
    {
        const int tt = w >> 1;
#pragma unroll
        for (int u = 0; u < 2; ++u) {
            const int st = 2 * (w & 1) + u;
            u32x2 o = (u32x2){0u, 0u};
            if (st <= tt) {
                f32x4 acc = (f32x4){0.f, 0.f, 0.f, 0.f};
#pragma unroll
                for (int ks = 0; ks < 4; ++ks) { const bf16x8 a = FRAG(H_KT + (16 * st + l15) * 272 + (32 * ks + 8 * q4) * 2), bq = FRAG(H_QT + (16 * tt + l15) * 272 + (32 * ks + 8 * q4) * 2); acc = MFMA16(a, bq, acc); }
                MFMA_SETTLE();
                const int tg = 16 * tt + l15, sg = 16 * st + 4 * q4;
                const float a0 = (sg + 0 <= tg) ? acc[0] : 0.f, a1 = (sg + 1 <= tg) ? acc[1] : 0.f, a2 = (sg + 2 <= tg) ? acc[2] : 0.f, a3 = (sg + 3 <= tg) ? acc[3] : 0.f;
                o.x = pk2(a0, a1); o.y = pk2(a2, a3);
            }
            *(LAS u32x2*)(lds + H_ATT + (16 * tt + l15) * 144 + (16 * st + 4 * q4) * 2) = o;
        }
    }
    __syncthreads();
    f32x4 O[4];
    const int tt = w & 3, vh = w >> 2, t = 16 * tt + l15;
    u32x2 gg[4]; f32x4 g4[4];
#pragma unroll
    for (int i = 0; i < 4; ++i) { const int vb = 16 * (4 * vh + i) + 4 * q4; g4[i] = *(const f32x4*)(og + vb);
        gg[i] = (t < nvalid) ? *(const u32x2*)(Gp + (size_t)(rbase + t) * 1024 + vb) : (u32x2){0u, 0u}; }
    {
        bf16x8 ab[2], qb[4];
#pragma unroll
        for (int ks = 0; ks < 2; ++ks) ab[ks] = FRAG(H_ATT + (16 * tt + l15) * 144 + (32 * ks + 8 * q4) * 2);
#pragma unroll
        for (int ks = 0; ks < 4; ++ks) qb[ks] = FRAG(H_QT + (16 * tt + l15) * 272 + (32 * ks + 8 * q4) * 2);
        float ssq = 0.f;
#pragma unroll
        for (int i = 0; i < 4; ++i) {
            const int vt = 4 * vh + i; f32x4 acc = (f32x4){0.f, 0.f, 0.f, 0.f};
#pragma unroll
            for (int ks = 0; ks < 2; ++ks) { const bf16x8 a = FRAG(H_VT + (16 * vt + l15) * 144 + (32 * ks + 8 * q4) * 2); acc = MFMA16(a, ab[ks], acc); }
#pragma unroll
            for (int ks = 0; ks < 4; ++ks) { const bf16x8 a = FRAG(H_ST + (16 * vt + l15) * 272 + (32 * ks + 8 * q4) * 2); acc = MFMA16(a, qb[ks], acc); }
            MFMA_SETTLE();
            O[i] = acc; ssq += (acc[0] * acc[0] + acc[1] * acc[1]) + (acc[2] * acc[2] + acc[3] * acc[3]);
        }
        ssq += __shfl_xor(ssq, 16); ssq += __shfl_xor(ssq, 32);
        if (q4 == 0) SSQf[vh * 64 + 16 * tt + l15] = ssq;
    }
    __syncthreads();
    {
        const float tot = SSQf[t] + SSQf[64 + t];
        const float rs = 1.0f / sqrtf(tot * (1.0f / 128.0f) + EPS);
        if (t < nvalid) {
#pragma unroll
            for (int i = 0; i < 4; ++i) { const int vb = 16 * (4 * vh + i) + 4 * q4;
                u32x2 o; o.x = pk2(O[i][0] * rs * g4[i][0] * bf_lo(gg[i].x), O[i][1] * rs * g4[i][1] * bf_hi(gg[i].x)); o.y = pk2(O[i][2] * rs * g4[i][2] * bf_lo(gg[i].y), O[i][3] * rs * g4[i][3] * bf_hi(gg[i].y));
                *(u32x2*)(MIXp + (size_t)(rbase + t) * 2048 + vb) = o; }
        }
    }
    __syncthreads();
}

__device__ __forceinline__ void s5_lbar(const Params& p, int gi, int n, float& lbr, float& lbi, float& cr, float& ci) {
    const float dt = expf(p.log_step[gi]);
    const float lr = p.lam_re[gi * 64 + n], li = p.lam_im[gi * 64 + n];
    const float mag = expf(dt * lr), ang = dt * li;
    const float kq = rintf(ang * 0.636619772f);
    float r = fmaf(-kq, 1.57079637f, ang); r = fmaf(-kq, -4.37113883e-8f, r);
    const int qi = ((int)kq) & 3;
    const float r2 = r * r;
    const float sn = r + r * r2 * (-1.66666667e-1f + r2 * (8.33333333e-3f + r2 * (-1.98412698e-4f + r2 * 2.75573192e-6f)));
    const float cs = 1.0f + r2 * (-0.5f + r2 * (4.16666667e-2f + r2 * (-1.38888889e-3f + r2 * (2.48015873e-5f + r2 * -2.75573192e-7f))));
    const float s_ = (qi == 0) ? sn : (qi == 1) ? cs : (qi == 2) ? -sn : -cs;
    const float c_ = (qi == 0) ? cs : (qi == 1) ? -sn : (qi == 2) ? -cs : sn;
    lbr = mag * c_; lbi = mag * s_;
    const float nr = lbr - 1.0f, ni = lbi, den = lr * lr + li * li;
    cr = (nr * lr + ni * li) / den; ci = (ni * lr - nr * li) / den;
}
template <int KIND>
__device__ __forceinline__ void s5_wave(LAS unsigned char* lds  , const Params& p, int l, int b, int g, int cc, int lane) {
    const int n = lane, q4 = lane >> 4, l15 = lane & 15;
    const int nsteps = KIND == 2 ? 32 : 256, row0 = KIND == 2 ? 8192 + b * 32 : b * 2048 + cc * 256;
    const int gi = l * 64 + g;
    float lbr, lbi, cr, ci;
    s5_lbar(p, gi, n, lbr, lbi, cr, ci);
    {
        const f32x4* Brp = (const f32x4*)(p.B_re + ((size_t)gi * 64 + n) * 16); const f32x4* Bip = (const f32x4*)(p.B_im + ((size_t)gi * 64 + n) * 16);
        unsigned re[8], im[8];
#pragma unroll
        for (int i = 0; i < 4; ++i) { const f32x4 br = Brp[i], bi = Bip[i];
            re[2 * i] = pk2(cr * br[0] - ci * bi[0], cr * br[1] - ci * bi[1]); re[2 * i + 1] = pk2(cr * br[2] - ci * bi[2], cr * br[3] - ci * bi[3]);
            im[2 * i] = pk2(cr * bi[0] + ci * br[0], cr * bi[1] + ci * br[1]); im[2 * i + 1] = pk2(cr * bi[2] + ci * br[2], cr * bi[3] + ci * br[3]); }
        LAS u32x4* d0 = (LAS u32x4*)(lds + n * 32); d0[0] = (u32x4){re[0], re[1], re[2], re[3]}; d0[1] = (u32x4){re[4], re[5], re[6], re[7]};
        LAS u32x4* d1 = (LAS u32x4*)(lds + (64 + n) * 32); d1[0] = (u32x4){im[0], im[1], im[2], im[3]}; d1[1] = (u32x4){im[4], im[5], im[6], im[7]};
    }
    LDS_FENCE();
    const bf16x8 zero8 = (bf16x8){0, 0, 0, 0, 0, 0, 0, 0};
    bf16x8 bbf[8];
#pragma unroll
    for (int j = 0; j < 8; ++j) { const bf16x8 t = *(const LAS bf16x8*)(lds + (16 * j + l15) * 32 + (q4 & 1) * 16); bbf[j] = (q4 < 2) ? t : zero8; }
    LDS_FENCE();
    bf16x8 cf[4]; f32x4 dv = (f32x4){0.f, 0.f, 0.f, 0.f};
    if (KIND != 0) {
#pragma unroll
        for (int ks = 0; ks < 4; ++ks) {
            const size_t ci_ = ((size_t)gi * 16 + l15) * 64 + 16 * ks + 4 * q4;
            const f32x4 cr4 = *(const f32x4*)(p.C_re + ci_), ci4 = *(const f32x4*)(p.C_im + ci_);
            const u32x4 wv = (u32x4){pk2(cr4[0], -ci4[0]), pk2(cr4[1], -ci4[1]), pk2(cr4[2], -ci4[2]), pk2(cr4[3], -ci4[3])};
            cf[ks] = __builtin_bit_cast(bf16x8, wv);
        }
        dv = *(const f32x4*)(p.s5_D + l * 1024 + g * 16 + 4 * q4);
    }
    float xr = 0.f, xi = 0.f;
    const size_t eidx = ((size_t)(b * 64 + g) * 8 + cc) * 64 + n;
    if (KIND == 1) {
        float ar = lbr, ai = lbi;
#pragma unroll
        for (int i = 0; i < 8; ++i) { const float nr = ar * ar - ai * ai, ni = 2.0f * ar * ai; ar = nr; ai = ni; }
        const float* se = (const float*)(p.ws + OFF_S5E); const size_t e0 = ((size_t)(b * 64 + g) * 8) * 64 + n;
        for (int j = 0; j < cc; ++j) { const float er = ld_dev_f32(se + e0 + j * 64), ei = ld_dev_f32(se + 131072 + e0 + j * 64);
            const float nxr = ar * xr - ai * xi + er, nxi = ar * xi + ai * xr + ei; xr = nxr; xi = nxi; }
    }
    if (KIND == 2) { xr = p.state_re[((size_t)(l * 16 + b) * 64 + g) * 64 + n]; xi = p.state_im[((size_t)(l * 16 + b) * 64 + g) * 64 + n]; }
    const bf16_t* Up = (const bf16_t*)(p.ws + OFF_U) + g * 16;
    bf16_t* HHp = (bf16_t*)(p.ws + OFF_HH) + g * 16;
    LAS float* BUf = (LAS float*)lds; LAS unsigned short* X16 = (LAS unsigned short*)(lds + 8448);
    u32x4 nu = (u32x4){0u, 0u, 0u, 0u};
    if (q4 < 2) nu = *(const u32x4*)(Up + (size_t)(row0 + l15) * 1024 + 8 * q4);
    for (int t0 = 0; t0 < nsteps; t0 += 16) {
        const bf16x8 uf = __builtin_bit_cast(bf16x8, nu);
        if (q4 < 2 && t0 + 16 < nsteps) nu = *(const u32x4*)(Up + (size_t)(row0 + t0 + 16 + l15) * 1024 + 8 * q4);
        const size_t row = (size_t)(row0 + t0 + l15);
        f32x4 u4 = (f32x4){0.f, 0.f, 0.f, 0.f};
        if (KIND != 0) { const u32x2 uw = *(const u32x2*)(Up + row * 1024 + 4 * q4); u4 = (f32x4){bf_lo(uw.x), bf_hi(uw.x), bf_lo(uw.y), bf_hi(uw.y)}; }
        f32x4 dd[8];
#pragma unroll
        for (int j = 0; j < 8; ++j) dd[j] = MFMA16(bbf[j], uf, ((f32x4){0.f, 0.f, 0.f, 0.f}));
        MFMA_SETTLE();
#pragma unroll
        for (int j = 0; j < 8; ++j) *(LAS f32x4*)(lds + (l15 * 132 + 16 * j + 4 * q4) * 4) = dd[j];
        LDS_FENCE();
#pragma unroll
        for (int t = 0; t < 16; ++t) {
            const float br = BUf[t * 132 + n], bi = BUf[t * 132 + 64 + n];
            const float nxr = fmaf(lbr, xr, fmaf(-lbi, xi, br)), nxi = fmaf(lbr, xi, fmaf(lbi, xr, bi));
            xr = nxr; xi = nxi;
            if (KIND != 0) *(LAS unsigned*)(lds + 8448 + t * 272 + n * 4) = pk2(xr, xi);
        }
        LDS_FENCE();
        if (KIND != 0) {
            f32x4 y = (f32x4){0.f, 0.f, 0.f, 0.f};
#pragma unroll
            for (int ks = 0; ks < 4; ++ks) { const bf16x8 xb = *(const LAS bf16x8*)(lds + 8448 + l15 * 272 + (32 * ks + 8 * q4) * 2); y = MFMA16(cf[ks], xb, y); }
            MFMA_SETTLE();
            LDS_FENCE();
            float hh[4];
#pragma unroll
            for (int j = 0; j < 4; ++j) { const float yy = y[j] + dv[j] * u4[j]; const float a = 0.7978845608028654f * (yy + 0.044715f * yy * yy * yy);
                const float e = __expf(2.0f * a); const float th = 1.0f - 2.0f / (e + 1.0f); hh[j] = 0.5f * yy * (1.0f + th); }
            u32x2 o; o.x = pk2(hh[0], hh[1]); o.y = pk2(hh[2], hh[3]);
            *(u32x2*)(HHp + row * 1024 + 4 * q4) = o;
        }
    }
    if (KIND == 0) { float* se = (float*)(p.ws + OFF_S5E); st_dev_f32(se + eidx, xr); st_dev_f32(se + 131072 + eidx, xi); }
    if (KIND == 1 && cc == 7) { const size_t o = ((size_t)(l * 4 + b) * 64 + g) * 64 + n; p.out[OUT_RP + o] = xr; p.out[OUT_IP + o] = xi; }
    if (KIND == 2) { const size_t idx = ((size_t)(l * 16 + b) * 64 + g) * 64 + n; p.out[OUT_RS + idx] = xr; p.out[OUT_IS + idx] = xi; }
}
__device__ __forceinline__ void phase_mix1(LAS unsigned char* lds, const Params& p, int l) {
    const int tid_ = otid(); const int w = tid_ >> 6, lane = tid_ & 63;
    for (int it = obid(); it < 1152 + 256; it += gridDim.x) {
        if (it < 1152) hgrn_m1_item(lds, p, l, it);
        else { const int id = (it - 1152) * 8 + w;
            s5_wave<0>(lds + w * 12800, p, l, id >> 9, id & 63, (id >> 6) & 7, lane); __syncthreads(); }
    }
}
__device__ __forceinline__ void phase_mix2(const Params& p, int l) { hgrn_m2(p, l); }
__device__ __forceinline__ void phase_mix3(LAS unsigned char* lds, const Params& p, int l) {
    const int tid_ = otid(); const int w = tid_ >> 6, lane = tid_ & 63;
    for (int it = obid(); it < 1152 + 256 + 128; it += gridDim.x) {
        if (it < 1152) hgrn_m3_item(lds, p, l, it);
        else if (it < 1152 + 128) { const int id = (it - 1152) * 8 + w;
            s5_wave<2>(lds + w * 12800, p, l, id >> 6, id & 63, 0, lane); __syncthreads(); }
        else { const int id = (it - 1152 - 128) * 8 + w;
            s5_wave<1>(lds + w * 12800, p, l, id >> 9, id & 63, (id >> 6) & 7, lane); __syncthreads(); }
    }
}

__device__ __forceinline__ void gemm_residual(LAS unsigned char* lds, const Params& p, const bf16_t* A, const bf16_t* Bt, int K, float* part, int splits) {
    const int G = gridDim.x, bid = obid();
    pg8::StaticOrder S; S.init(M, D, G, bid);
    EpiRes E; E.X = p.out;
    if (G != 256) { pg8::gemm_phase(lds, pg8::Gemm{A, Bt, M, D, K, K}, S, E); return; }
    pg8::OneUnit S1; S1.valid = S.next(0, S1.u);
    pg8::gemm_phase(lds, pg8::Gemm{A, Bt, M, D, K, K}, S1, E);
    const int j = bid / splits, ks = bid % splits, Ksub = K / splits;
    pg8::OneUnit S2; S2.valid = false;
    if (j < 16) { pg8::StaticOrder T; T.init(M, D, G, j); S2.valid = T.next(1, S2.u); }
    EpiPart EP; EP.P = part + (size_t)(j * splits + ks) * 65536;
    pg8::gemm_phase(lds, pg8::Gemm{A + (size_t)ks * Ksub, Bt + (size_t)ks * Ksub, M, D, Ksub, K}, S2, EP);
}

__device__ __forceinline__ void run_phase(LAS unsigned char* lds, const Params& p, int ph) {
    if (ph == 0) { if (PH_MASK & 256) phase0(lds, p); return; }
    const int l = (ph - 1) / 10, s = (ph - 1) % 10;
    pg8::StaticOrder S;
    bf16_t* H = (bf16_t*)(p.ws + OFF_H); bf16_t* MIX = (bf16_t*)(p.ws + OFF_MIX); bf16_t* HH = (bf16_t*)(p.ws + OFF_HH); bf16_t* ACT = (bf16_t*)(p.ws + OFF_R);
    switch (s) {
    case 0: if (PH_MASK & 1) { S.init(M, INC, gridDim.x, obid());
        EpiIn E; E.Q = (float*)(p.ws + OFF_Q); E.LOGF = (float*)(p.ws + OFF_LOGF); E.U = (float*)(p.ws + OFF_U); E.V = (bf16_t*)(p.ws + OFF_V); E.G = (bf16_t*)(p.ws + OFF_G); E.LB = (const float*)(p.ws + OFF_LB) + l * 1024;
        pg8::gemm_phase(lds, pg8::Gemm{H, (const bf16_t*)(p.ws + OFF_WIN + l * SZ_WIN), M, INC, D, D}, S, E);
        bg_convert(lds, p, 168, l, BG_A_START, BG_A_N); } break;
    case 1: if (PH_MASK & 2) phase_mix1(lds, p, l); break;
    case 2: if (PH_MASK & 2) phase_mix2(p, l); break;
    case 3: if (PH_MASK & 2) phase_mix3(lds, p, l); break;
    case 4: if (PH_MASK & 4) { S.init(M, 1024, gridDim.x, obid());
        EpiGlu E; E.MIX = MIX; E.HH = HH; E.bias = p.b_glu + l * 1024;
        pg8::gemm_phase(lds, pg8::Gemm{HH, (const bf16_t*)(p.ws + OFF_WGLU + l * SZ_WGLU), M, 1024, 1024, 1024}, S, E);
        bg_convert(lds, p, 136, l, BG_B_START, BG_B_N); } break;
    case 5: if (PH_MASK & 8) { gemm_residual(lds, p, MIX, (const bf16_t*)(p.ws + OFF_WOUT + l * SZ_WOUT), D, (float*)(p.ws + OFF_HH), 4);
        bg_convert(lds, p, 64, l, BG_O_START, BG_O_N); } break;
    case 6: if (PH_MASK & 16) phase_norm_parts(p, p.norm2_g + l * D, false, (const float*)(p.ws + OFF_HH), 4); break;
    case 7: if (PH_MASK & 32) { S.init(M, DFF, gridDim.x, obid());
        EpiFF1 E; E.ACT = ACT;
        pg8::gemm_phase(lds, pg8::Gemm{H, (const bf16_t*)(p.ws + OFF_WFF1 + l * SZ_WFF1), M, DFF, D, D}, S, E);
        bg_convert(lds, p, 64, l, BG_C_START, BG_C_N); if (l == 0) bg_convert(lds, p, 64, 1, 0, BG_C0_EXTRA); } break;
    case 8: if (PH_MASK & 64) { gemm_residual(lds, p, ACT, (const bf16_t*)(p.ws + OFF_WFF2 + l * SZ_WFF2), DFF, (float*)(p.ws + OFF_MIX), 8);
        if (l == 0) bg_convert(lds, p, 128, 1, BG_F0_START, BG_F0_N); } break;
    default: if (PH_MASK & 128) { if (l == 0) phase_norm_parts(p, p.norm1_g + D, false, (const float*)(p.ws + OFF_MIX), 8); else phase_norm_parts(p, p.final_g, true, (const float*)(p.ws + OFF_MIX), 8); } break;
    }
}

struct BarState { unsigned* w; unsigned xid, cen, nx, k; };
__device__ __forceinline__ void grid_barrier(BarState& B) {
    asm volatile("s_waitcnt vmcnt(0) lgkmcnt(0)" ::: "memory");
    __syncthreads();
    if (threadIdx.x < 64) {
        if (threadIdx.x == 0) {
            const unsigned k = ++B.k;
            const unsigned o = __hip_atomic_fetch_add(B.w + 64 * (9 + B.xid), 1u, __ATOMIC_RELAXED, __HIP_MEMORY_SCOPE_AGENT) + 1u;
            if (o == k * B.cen) {
                __builtin_amdgcn_fence(__ATOMIC_RELEASE, "agent"); asm volatile("s_waitcnt vmcnt(0)" ::: "memory");
                const unsigned t = __hip_atomic_fetch_add(B.w + 64 * 17, 1u, __ATOMIC_RELAXED, __HIP_MEMORY_SCOPE_AGENT) + 1u;
                if (t == k * B.nx) __hip_atomic_store(B.w + 64 * 18, k, __ATOMIC_RELAXED, __HIP_MEMORY_SCOPE_AGENT);
            }
            while (__hip_atomic_load(B.w + 64 * 18, __ATOMIC_RELAXED, __HIP_MEMORY_SCOPE_AGENT) < k) __builtin_amdgcn_s_sleep(BAR_SLEEP);
        }
        __builtin_amdgcn_fence(__ATOMIC_ACQUIRE, "agent"); asm volatile("s_waitcnt vmcnt(0)" ::: "memory");
    }
    __syncthreads();
}
__global__ void __launch_bounds__(512, 2) mega(Params p) {
    extern __shared__ __attribute__((aligned(16))) unsigned char shm[];
    LAS unsigned char* lds = (LAS unsigned char*)shm;
    cg::grid_group grid = cg::this_grid();
    BarState B; B.w = (unsigned*)(p.ws + OFF_BAR); B.xid = (unsigned)__builtin_amdgcn_s_getreg((3 << 11) | 20) & 7u; B.cen = 0; B.nx = 0; B.k = 0;
    if (threadIdx.x == 0) __hip_atomic_fetch_add(B.w + 64 * (1 + B.xid), 1u, __ATOMIC_RELAXED, __HIP_MEMORY_SCOPE_AGENT);
    grid.sync();
    if (threadIdx.x == 0) {
        for (unsigned j = 0; j < 8; ++j) { const unsigned c = __hip_atomic_load(B.w + 64 * (1 + j), __ATOMIC_RELAXED, __HIP_MEMORY_SCOPE_AGENT); if (j == B.xid) B.cen = c; B.nx += (c != 0u) ? 1u : 0u; }
    }
    for (int i = 0; i < EXTRA_BARS; ++i) grid_barrier(B);
    for (int ph = p.ph_lo; ph < p.ph_hi; ++ph) {
        run_phase(lds, p, ph);
        if (ph + 1 < p.ph_hi) grid_barrier(B);
    }
}

extern "C" void kernel_launch(void* const* d_in, const int* in_sizes, int n_in, void* d_out, int out_size, void* d_ws, size_t ws_size, hipStream_t stream) {
    static int grid_blocks = 0;
    if (!grid_blocks) {
        int dev = 0, cus = 0, per_cu = 0;
        hipGetDevice(&dev);
        hipDeviceGetAttribute(&cus, hipDeviceAttributeMultiprocessorCount, dev);
        if (hipFuncSetAttribute((const void*)mega, hipFuncAttributeMaxDynamicSharedMemorySize, LDS_BYTES) != hipSuccess) fprintf(stderr, "hipFuncSetAttribute failed\n");
        if (hipOccupancyMaxActiveBlocksPerMultiprocessor(&per_cu, (const void*)mega, 512, LDS_BYTES) != hipSuccess || per_cu < 1) { fprintf(stderr, "occupancy query: %d\n", per_cu); per_cu = 1; }
        (void)hipGetLastError();
        if (per_cu > 1) per_cu = 1;
        grid_blocks = cus * per_cu;
        if (grid_blocks != 256) { fprintf(stderr, "this kernel's work schedule is built for 256 co-resident workgroups (one per CU of a 256-CU device); got %d; nothing launched\n", grid_blocks); grid_blocks = -1; }
        else if (ws_size < WS_END) { fprintf(stderr, "workspace too small: %zu < %zu; nothing launched\n", ws_size, (size_t)WS_END); grid_blocks = -1; }
    }
    if (grid_blocks < 0) return;
    (void)hipMemsetAsync((unsigned char*)d_ws + OFF_BAR, 0, 8192, stream);
    Params p{};
    const float** pf = (const float**)&p;
    for (int i = 0; i < 24; ++i) pf[i] = (const float*)d_in[i];
    p.out = (float*)d_out; p.ws = (unsigned char*)d_ws;
#if ONE_LAUNCH
    p.ph_lo = 0; p.ph_hi = NPH;
    { void* args[] = {&p};
      hipError_t e = hipLaunchCooperativeKernel((const void*)mega, dim3(grid_blocks), dim3(512), args, LDS_BYTES, stream);
      if (e != hipSuccess) fprintf(stderr, "cooperative launch failed: %s (grid %d)\n", hipGetErrorString(e), grid_blocks); }
#else
    for (int ph = 0; ph < NPH; ++ph) {
        p.ph_lo = ph; p.ph_hi = ph + 1;
        void* args[] = {&p};
        hipError_t e = hipLaunchCooperativeKernel((const void*)mega, dim3(grid_blocks), dim3(512), args, LDS_BYTES, stream);
        if (e != hipSuccess) { fprintf(stderr, "launch %d failed: %s (grid %d)\n", ph, hipGetErrorString(e), grid_blocks); break; }
    }
#endif
}
```

```cpp
#include <hip/hip_runtime.h>
#include <hip/hip_cooperative_groups.h>
#include <cstdio>
#include <cstdint>
namespace cg = cooperative_groups;

#ifndef ONE_LAUNCH
#define ONE_LAUNCH 1
#endif

#ifndef MIX_MASK
#define MIX_MASK 3
#endif
#ifndef EXTRA_BARS
#define EXTRA_BARS 0
#endif
#ifndef BAR_SLEEP
#define BAR_SLEEP 1
#endif
#ifndef PH_MASK
#define PH_MASK 0x1ff
#endif
#define LAS __attribute__((address_space(3)))
typedef unsigned short bf16_t;
typedef short bf16x8 __attribute__((ext_vector_type(8)));
typedef float f32x4 __attribute__((ext_vector_type(4)));
typedef unsigned u32x4 __attribute__((ext_vector_type(4)));
typedef unsigned u32x2 __attribute__((ext_vector_type(2)));

constexpr int D = 2048, M = 8704, DFF = 8192, INC = 5120, NPH = 21;
constexpr float EPS = 1e-6f;
constexpr size_t OUT_HP = 17825792, OUT_RP = 18874368, OUT_IP = 18907136, OUT_HS = 18939904, OUT_RS = 23134208, OUT_IS = 23265280;
constexpr size_t SZ_WIN = (size_t)INC * D * 2, SZ_WGLU = (size_t)1024 * 1024 * 2, SZ_WOUT = (size_t)D * D * 2, SZ_WFF1 = (size_t)DFF * D * 2, SZ_WFF2 = (size_t)D * DFF * 2;
constexpr size_t OFF_WIN = 0, OFF_WGLU = OFF_WIN + 2 * SZ_WIN, OFF_WOUT = OFF_WGLU + 2 * SZ_WGLU, OFF_WFF1 = OFF_WOUT + 2 * SZ_WOUT, OFF_WFF2 = OFF_WFF1 + 2 * SZ_WFF1;
constexpr size_t OFF_H = OFF_WFF2 + 2 * SZ_WFF2, OFF_MIX = OFF_H + (size_t)M * D * 2, OFF_HH = OFF_MIX + (size_t)M * D * 2, OFF_LB = OFF_HH + (size_t)M * 1024 * 2;
constexpr size_t OFF_R = OFF_LB + 8192;
constexpr size_t OFF_Q = OFF_R, OFF_LOGF = OFF_Q + (size_t)M * 1024 * 4, OFF_U = OFF_LOGF + (size_t)M * 1024 * 4, OFF_V = OFF_U + (size_t)M * 1024 * 4, OFF_G = OFF_V + (size_t)M * 1024 * 2;
constexpr size_t OFF_SP = OFF_H;
constexpr size_t OFF_DS = OFF_MIX;
constexpr size_t OFF_DEC = OFF_H + 33554432, OFF_S5E = OFF_DEC + 1048576;
static_assert(OFF_S5E + 1048576 <= OFF_MIX, "H tail");
constexpr size_t OFF_BAR = OFF_R + (size_t)M * DFF * 2;
constexpr size_t WS_END = OFF_BAR + 8192;
static_assert(OFF_G + (size_t)M * 1024 * 2 <= OFF_BAR, "overlay");

constexpr int LDS_BYTES = 154112;

struct Params {
    const float *x_prompt, *x_sample, *state_hgrn, *state_re, *state_im, *norm1_g, *w_in, *lb_logits, *onorm_g, *lam_re, *lam_im, *log_step,
        *B_re, *B_im, *C_re, *C_im, *s5_D, *w_glu, *b_glu, *w_out, *norm2_g, *w_ff1, *w_ff2, *final_g;
    float* out;
    unsigned char* ws;
    int ph_lo, ph_hi;
};

typedef __bf16 bf16x2_t __attribute__((ext_vector_type(2)));
__device__ __forceinline__ unsigned pk2(float lo, float hi) { bf16x2_t v; v.x = (__bf16)lo; v.y = (__bf16)hi; return __builtin_bit_cast(unsigned, v); }
__device__ __forceinline__ float bf_lo(unsigned w) { return __uint_as_float(w << 16); }
__device__ __forceinline__ float bf_hi(unsigned w) { return __uint_as_float(w & 0xffff0000u); }
__device__ __forceinline__ float sigmoidf_(float z) { return 1.0f / (1.0f + __expf(-z)); }
__device__ __forceinline__ float siluf_(float z) { return z / (1.0f + __expf(-z)); }
__device__ __forceinline__ int otid() { int t = threadIdx.x; asm volatile("" : "+v"(t)); return t; }
__device__ __forceinline__ int obid() { int t = blockIdx.x; asm volatile("" : "+s"(t)); return t; }
__device__ __forceinline__ float ld_dev_f32(const float* q) { return *q; }
__device__ __forceinline__ void st_dev_f32(float* q, float v) { *q = v; }
__device__ __forceinline__ u32x2 ld_dev_u32x2(const void* q) { return *(const u32x2*)q; }
__device__ __forceinline__ void st_dev_u32x2(void* q, u32x2 v) { *(u32x2*)q = v; }
#define MFMA_SETTLE() do { __builtin_amdgcn_sched_barrier(0); asm volatile("s_nop 15\n\ts_nop 15\n\ts_nop 15\n\ts_nop 15" ::: "memory"); __builtin_amdgcn_sched_barrier(0); } while (0)
#define LDS_FENCE() asm volatile("s_waitcnt lgkmcnt(0)" ::: "memory")

namespace pg8 {
constexpr int BM = 256, BK = 64, HALF = 128, HTB = HALF * BK * 2, STAGE_BYTES = 8 * HTB, NXCD = 8, WGM = 8;
__host__ __device__ __forceinline__ int lds_byte(int r, int c) { const int st = (r >> 4) * 2 + (c >> 5), rr = r & 15, cc = c & 31, ob = rr * 64 + cc * 2; return st * 1024 + (ob ^ (((ob >> 9) & 1) << 5)); }
__host__ __device__ __forceinline__ void stage_rc(int b, int& R, int& C) { const int st = b / 1024, sb = b % 1024, swz = sb ^ (((sb >> 9) & 1) << 5); R = (st >> 1) * 16 + swz / 64; C = (st & 1) * 32 + (swz % 64) / 2; }
__host__ __device__ __forceinline__ int perm32(int rho) { const int n = rho >> 4, i = rho & 15; return 8 * (i >> 2) + 4 * n + (i & 3); }
struct Unit { int pm, pn; };
struct Gemm { const bf16_t* A; const bf16_t* Bt; int M, N, K, LD; };
struct StaticOrder {
    int nM, nN, nwg, G, c;
    __host__ __device__ void init(int M_, int N_, int G_, int c_) { nM = M_ / BM; nN = N_ / BM; nwg = nM * nN; G = G_; c = c_; }
    __host__ __device__ bool next(int i, Unit& u) const {
        const long L = (long)i * G + c; if (L >= nwg) return false;
        int wgid = (int)L; { const int q = nwg / NXCD, r = nwg % NXCD, xcd = wgid % NXCD, off = wgid / NXCD; wgid = (xcd < r ? xcd * (q + 1) : r * (q + 1) + (xcd - r) * q) + off; }
        const int nig = WGM * nN, gid = wgid / nig, fm = gid * WGM, gsz = (nM - fm) < WGM ? (nM - fm) : WGM;
        u.pm = fm + ((wgid % nig) % gsz); u.pn = (wgid % nig) / gsz; return true;
    }
    __device__ __forceinline__ void a_ready(const Unit&) const {}
    __device__ __forceinline__ void done(const Unit&) const {}
};

struct OneUnit {
    Unit u; bool valid;
    __device__ __forceinline__ bool next(int i, Unit& o) const { if (i != 0 || !valid) return false; o = u; return true; }
    __device__ __forceinline__ void a_ready(const Unit&) const {}
    __device__ __forceinline__ void done(const Unit&) const {}
};

template <class Epi, class Sched, bool ALIGN_EPI = true, bool SP2 = true>
__device__ __forceinline__ void gemm_phase(LAS unsigned char* lds, const Gemm g, const Sched& S, const Epi& E) {
    const int tid = otid(), wid = __builtin_amdgcn_readfirstlane(tid >> 6), lane = tid & 63, wr = wid >> 2, wc = wid & 3, fr = lane & 15, fq = lane >> 4;
    const int K = g.K, LD = g.LD, nt = K / BK;
    unsigned voffA[2], voffB[2];
#pragma unroll
    for (int i = 0; i < 2; ++i) { int R, C; stage_rc(tid * 16 + i * 8192, R, C); const int Rb = Epi::PERM ? ((R & ~31) + perm32(R & 31)) : R;
        voffA[i] = (unsigned)(R * LD + C) * 2u; voffB[i] = (unsigned)(Rb * LD + C) * 2u; }
    const size_t kstep = (size_t)(BK * 2);
    const size_t hstep = (size_t)HALF * LD * 2;
    const size_t tstep = 2 * hstep;
    const unsigned ldsw = (unsigned)wid * 1024u;
    const int aoff = lds_byte(wr * 64 + fr, fq * 8), boff = lds_byte(wc * 32 + fr, fq * 8);
#define PG8_SA(b, h) (((b) * 2 + (h)) * HTB)
#define PG8_SB(b, h) ((4 + (b) * 2 + (h)) * HTB)
#define PG8_STAGE(bufoff, gbase, voff) do { _Pragma("unroll") for (int _i = 0; _i < 2; ++_i) \
        __builtin_amdgcn_global_load_lds((const unsigned*)((const char*)(gbase) + (voff)[_i]), (LAS unsigned*)(lds + (bufoff) + ldsw + _i * 8192), 16, 0, 0); } while (0)
#define PG8_LDA(dst, b, h) do { _Pragma("unroll") for (int m = 0; m < 4; ++m) _Pragma("unroll") for (int k = 0; k < 2; ++k) dst[m][k] = *(const LAS bf16x8*)(lds + PG8_SA(b, h) + aoff + m * 2048 + k * 1024); } while (0)
#define PG8_LDB(dst, b, h) do { _Pragma("unroll") for (int n = 0; n < 2; ++n) _Pragma("unroll") for (int k = 0; k < 2; ++k) dst[n][k] = *(const LAS bf16x8*)(lds + PG8_SB(b, h) + boff + n * 2048 + k * 1024); } while (0)
#define PG8_MMA(ai, bj, At, Bt) do { __builtin_amdgcn_s_setprio(1); _Pragma("unroll") for (int m = 0; m < 4; ++m) _Pragma("unroll") for (int n = 0; n < 2; ++n) _Pragma("unroll") for (int k = 0; k < 2; ++k) \
        acc[ai][bj][m][n] = __builtin_amdgcn_mfma_f32_16x16x32_bf16(Bt[n][k], At[m][k], acc[ai][bj][m][n], 0, 0, 0); __builtin_amdgcn_s_setprio(0); } while (0)
#define PG8_WAIT_V(n) asm volatile("s_waitcnt vmcnt(" #n ")" ::: "memory")
#define PG8_WAIT_L(n) asm volatile("s_waitcnt lgkmcnt(" #n ")" ::: "memory")
#define PG8_BAR __builtin_amdgcn_s_barrier()
#define PG8_SCHED __builtin_amdgcn_sched_barrier(0)
    Unit cur, nxt; int ui = 0;
    if (!S.next(0, cur)) return;
    f32x4 acc[2][2][4][2];
#pragma unroll
    for (int a = 0; a < 2; ++a)
#pragma unroll
        for (int b = 0; b < 2; ++b)
#pragma unroll
            for (int m = 0; m < 4; ++m)
#pragma unroll
                for (int n = 0; n < 2; ++n) acc[a][b][m][n] = (f32x4){0.f, 0.f, 0.f, 0.f};
    bf16x8 At[4][2], B0[2][2], B1[2][2];
    const char* cA = (const char*)g.A + (size_t)cur.pm * tstep; const char* cB = (const char*)g.Bt + (size_t)cur.pn * tstep;
    S.a_ready(cur);
    if constexpr (SP2) {
        PG8_STAGE(PG8_SB(0, 0), cB, voffB); PG8_STAGE(PG8_SB(0, 1), cB + hstep, voffB); PG8_STAGE(PG8_SA(0, 0), cA, voffA); PG8_STAGE(PG8_SA(0, 1), cA + hstep, voffA);
        if (wr == 1) PG8_BAR;
        PG8_WAIT_V(2); PG8_BAR;
        PG8_STAGE(PG8_SB(1, 0), cB + kstep, voffB); PG8_STAGE(PG8_SA(1, 0), cA + kstep, voffA); PG8_STAGE(PG8_SB(1, 1), cB + hstep + kstep, voffB);
        PG8_WAIT_V(6); PG8_BAR;
    } else {
        PG8_STAGE(PG8_SB(0, 0), cB, voffB); PG8_STAGE(PG8_SA(0, 0), cA, voffA); PG8_STAGE(PG8_SB(0, 1), cB + hstep, voffB); PG8_STAGE(PG8_SA(0, 1), cA + hstep, voffA);
        if (wr == 1) PG8_BAR;
        PG8_WAIT_V(4); PG8_BAR;
        PG8_STAGE(PG8_SB(1, 0), cB + kstep, voffB); PG8_STAGE(PG8_SA(1, 0), cA + kstep, voffA); PG8_STAGE(PG8_SB(1, 1), cB + hstep + kstep, voffB);
        PG8_WAIT_V(6); PG8_BAR;
    }
    for (;;) {
        const bool has_next = S.next(ui + 1, nxt);
        const char* nA = has_next ? (const char*)g.A + (size_t)nxt.pm * tstep : cA; const char* nB = has_next ? (const char*)g.Bt + (size_t)nxt.pn * tstep : cB;
        for (int t = 0; t < nt; t += 2) {
            const bool last = (t == nt - 2);
            const char* a1 = cA + (size_t)(t + 1) * kstep;
            const char* a2 = last ? nA : cA + (size_t)(t + 2) * kstep; const char* b2 = last ? nB : cB + (size_t)(t + 2) * kstep;
            const char* a3 = a2 + kstep; const char* b3 = b2 + kstep;
            if (last && has_next) S.a_ready(nxt);
            if constexpr (SP2) {
            PG8_LDB(B0, 0, 0); PG8_LDB(B1, 0, 1); PG8_SCHED; PG8_LDA(At, 0, 0); PG8_STAGE(PG8_SA(1, 1), a1 + hstep, voffA);
            PG8_WAIT_V(8); PG8_WAIT_L(0); PG8_BAR; PG8_MMA(0, 0, At, B0); PG8_MMA(0, 1, At, B1); PG8_BAR; PG8_SCHED;
            PG8_LDA(At, 0, 1); PG8_STAGE(PG8_SB(0, 0), b2, voffB); PG8_STAGE(PG8_SB(0, 1), b2 + hstep, voffB); PG8_STAGE(PG8_SA(0, 0), a2, voffA);
            PG8_WAIT_V(8); PG8_WAIT_L(0); PG8_BAR; PG8_MMA(1, 0, At, B0); PG8_MMA(1, 1, At, B1); PG8_BAR; PG8_SCHED;
            PG8_LDB(B0, 1, 0); PG8_LDB(B1, 1, 1); PG8_SCHED; PG8_LDA(At, 1, 0); PG8_STAGE(PG8_SA(0, 1), a2 + hstep, voffA);
            PG8_WAIT_V(8); PG8_WAIT_L(0); PG8_BAR; PG8_MMA(0, 0, At, B0); PG8_MMA(0, 1, At, B1); PG8_BAR; PG8_SCHED;
            PG8_LDA(At, 1, 1); PG8_STAGE(PG8_SB(1, 0), b3, voffB); PG8_STAGE(PG8_SB(1, 1), b3 + hstep, voffB); PG8_STAGE(PG8_SA(1, 0), a3, voffA);
            PG8_WAIT_V(8); PG8_WAIT_L(0); PG8_BAR; PG8_MMA(1, 0, At, B0); PG8_MMA(1, 1, At, B1); PG8_BAR; PG8_SCHED;
            } else {
            PG8_LDB(B0, 0, 0); PG8_SCHED; PG8_LDA(At, 0, 0); PG8_STAGE(PG8_SA(1, 1), a1 + hstep, voffA);
            PG8_WAIT_L(8); PG8_BAR; PG8_WAIT_L(0); PG8_MMA(0, 0, At, B0); PG8_BAR; PG8_SCHED;
            PG8_LDB(B1, 0, 1); PG8_STAGE(PG8_SB(0, 0), b2, voffB);
            PG8_BAR; PG8_WAIT_L(0); PG8_MMA(0, 1, At, B1); PG8_BAR;
            PG8_LDA(At, 0, 1); PG8_STAGE(PG8_SA(0, 0), a2, voffA);
            PG8_BAR; PG8_WAIT_L(0); PG8_MMA(1, 0, At, B0); PG8_BAR; PG8_SCHED;
            PG8_STAGE(PG8_SB(0, 1), b2 + hstep, voffB);
            PG8_WAIT_V(6); PG8_BAR; PG8_MMA(1, 1, At, B1); PG8_BAR;
            PG8_LDB(B0, 1, 0); PG8_SCHED; PG8_LDA(At, 1, 0); PG8_STAGE(PG8_SA(0, 1), a2 + hstep, voffA);
            PG8_WAIT_L(8); PG8_BAR; PG8_WAIT_L(0); PG8_MMA(0, 0, At, B0); PG8_BAR; PG8_SCHED;
            PG8_LDB(B1, 1, 1); PG8_STAGE(PG8_SB(1, 0), b3, voffB);
            PG8_BAR; PG8_WAIT_L(0); PG8_MMA(0, 1, At, B1); PG8_BAR;
            PG8_LDA(At, 1, 1); PG8_STAGE(PG8_SA(1, 0), a3, voffA);
            PG8_BAR; PG8_WAIT_L(0); PG8_MMA(1, 0, At, B0); PG8_BAR; PG8_SCHED;
            PG8_STAGE(PG8_SB(1, 1), b3 + hstep, voffB);
            PG8_WAIT_V(6); PG8_BAR; PG8_MMA(1, 1, At, B1); PG8_BAR;
            }
        }
        if constexpr (ALIGN_EPI) { if (wr == 0) PG8_BAR; }
        MFMA_SETTLE();
        E(acc, cur, wr, wc, fr, fq); S.done(cur);
        if (!has_next) break;
#pragma unroll
        for (int a = 0; a < 2; ++a)
#pragma unroll
            for (int b = 0; b < 2; ++b)
#pragma unroll
                for (int m = 0; m < 4; ++m)
#pragma unroll
                    for (int n = 0; n < 2; ++n) acc[a][b][m][n] = (f32x4){0.f, 0.f, 0.f, 0.f};
        cur = nxt; cA = nA; cB = nB; ++ui;
        if constexpr (ALIGN_EPI) { if (wr == 1) PG8_BAR; }
    }
    PG8_WAIT_V(0);
    if constexpr (!ALIGN_EPI) { if (wr == 0) PG8_BAR; }
    PG8_BAR;
#undef PG8_SA
#undef PG8_SB
#undef PG8_STAGE
#undef PG8_LDA
#undef PG8_LDB
#undef PG8_MMA
#undef PG8_WAIT_V
#undef PG8_WAIT_L
#undef PG8_BAR
#undef PG8_SCHED
}
}

typedef f32x4 AccT[2][2][4][2];

struct EpiIn {
    static constexpr bool PERM = true;
    float *Q, *LOGF, *U; bf16_t *V, *G; const float* LB;
    __device__ __forceinline__ void operator()(const AccT& acc, const pg8::Unit& u, int wr, int wc, int fr, int fq) const {
        const int row0 = u.pm * 256 + wr * 64 + fr, sect = u.pn >> 2, colb = (u.pn & 3) * 256 + wc * 32 + 8 * fq;
        if (false) {
        } else if (sect == 1) {
            f32x4 lb[2][2];
#pragma unroll
            for (int bj = 0; bj < 2; ++bj)
#pragma unroll
                for (int n = 0; n < 2; ++n) lb[bj][n] = *(const f32x4*)(LB + colb + bj * 128 + n * 4);
#pragma unroll
            for (int ai = 0; ai < 2; ++ai)
#pragma unroll
                for (int m = 0; m < 4; ++m) { float* rp = LOGF + (size_t)(row0 + ai * 128 + m * 16) * 1024 + colb;
#pragma unroll
                    for (int bj = 0; bj < 2; ++bj)
#pragma unroll
                        for (int n = 0; n < 2; ++n) { f32x4 v = acc[ai][bj][m][n], o;
#pragma unroll
                            for (int j = 0; j < 4; ++j) { const float l_ = lb[bj][n][j]; const float f = l_ + (1.0f - l_) * sigmoidf_(v[j]); o[j] = logf(f); }
                            *(f32x4*)(rp + bj * 128 + n * 4) = o; } }
        } else {
            bf16_t* dst = sect == 0 ? (bf16_t*)Q : sect == 2 ? V : sect == 3 ? G : (bf16_t*)U;
#pragma unroll
            for (int ai = 0; ai < 2; ++ai)
#pragma unroll
                for (int m = 0; m < 4; ++m) { bf16_t* rp = dst + (size_t)(row0 + ai * 128 + m * 16) * 1024 + colb;
#pragma unroll
                    for (int bj = 0; bj < 2; ++bj) { f32x4 v0 = acc[ai][bj][m][0], v1 = acc[ai][bj][m][1];
                        if (sect == 0 || sect == 3) {
#pragma unroll
                            for (int j = 0; j < 4; ++j) { v0[j] = siluf_(v0[j]); v1[j] = siluf_(v1[j]); } }
                        u32x4 w; w.x = pk2(v0[0], v0[1]); w.y = pk2(v0[2], v0[3]); w.z = pk2(v1[0], v1[1]); w.w = pk2(v1[2], v1[3]);
                        *(u32x4*)(rp + bj * 128) = w; } }
        }
    }
};
struct EpiGlu {
    static constexpr bool PERM = true;
    bf16_t* MIX; const bf16_t* HH; const float* bias;
    __device__ __forceinline__ void operator()(const AccT& acc, const pg8::Unit& u, int wr, int wc, int fr, int fq) const {
        const int row0 = u.pm * 256 + wr * 64 + fr, colb = u.pn * 256 + wc * 32 + 8 * fq;
        f32x4 bv[2][2];
#pragma unroll
        for (int bj = 0; bj < 2; ++bj)
#pragma unroll
            for (int n = 0; n < 2; ++n) bv[bj][n] = *(const f32x4*)(bias + colb + bj * 128 + n * 4);
#pragma unroll
        for (int ai = 0; ai < 2; ++ai)
#pragma unroll
            for (int m = 0; m < 4; ++m) { const size_t r = (size_t)(row0 + ai * 128 + m * 16);
#pragma unroll
                for (int bj = 0; bj < 2; ++bj) { const u32x4 hw = *(const u32x4*)(HH + r * 1024 + colb + bj * 128);
                    const f32x4 v0 = acc[ai][bj][m][0] + bv[bj][0], v1 = acc[ai][bj][m][1] + bv[bj][1];
                    u32x4 w;
                    w.x = pk2(bf_lo(hw.x) * sigmoidf_(v0[0]), bf_hi(hw.x) * sigmoidf_(v0[1])); w.y = pk2(bf_lo(hw.y) * sigmoidf_(v0[2]), bf_hi(hw.y) * sigmoidf_(v0[3]));
                    w.z = pk2(bf_lo(hw.z) * sigmoidf_(v1[0]), bf_hi(hw.z) * sigmoidf_(v1[1])); w.w = pk2(bf_lo(hw.w) * sigmoidf_(v1[2]), bf_hi(hw.w) * sigmoidf_(v1[3]));
                    *(u32x4*)(MIX + r * 2048 + 1024 + colb + bj * 128) = w; } }
    }
};
struct EpiRes {
    static constexpr bool PERM = true;
    float* X;
    __device__ __forceinline__ void operator()(const AccT& acc, const pg8::Unit& u, int wr, int wc, int fr, int fq) const {
        const int row0 = u.pm * 256 + wr * 64 + fr, colb = u.pn * 256 + wc * 32 + 8 * fq;
#pragma unroll
        for (int ai = 0; ai < 2; ++ai)
#pragma unroll
            for (int m = 0; m < 4; ++m) { float* rp = X + (size_t)(row0 + ai * 128 + m * 16) * 2048 + colb;
#pragma unroll
                for (int bj = 0; bj < 2; ++bj)
#pragma unroll
                    for (int n = 0; n < 2; ++n) { f32x4* pp = (f32x4*)(rp + bj * 128 + n * 4); *pp = *pp + acc[ai][bj][m][n]; } }
    }
};
struct EpiPart {
    static constexpr bool PERM = true;
    float* P;
    __device__ __forceinline__ void operator()(const AccT& acc, const pg8::Unit& u, int wr, int wc, int fr, int fq) const {
        const int row0 = wr * 64 + fr, colb = wc * 32 + 8 * fq;
#pragma unroll
        for (int ai = 0; ai < 2; ++ai)
#pragma unroll
            for (int m = 0; m < 4; ++m) { float* rp = P + (size_t)(row0 + ai * 128 + m * 16) * 256 + colb;
#pragma unroll
                for (int bj = 0; bj < 2; ++bj)
#pragma unroll
                    for (int n = 0; n < 2; ++n) *(f32x4*)(rp + bj * 128 + n * 4) = acc[ai][bj][m][n]; }
    }
};
struct EpiFF1 {
    static constexpr bool PERM = true;
    bf16_t* ACT;
    __device__ __forceinline__ void operator()(const AccT& acc, const pg8::Unit& u, int wr, int wc, int fr, int fq) const {
        const int row0 = u.pm * 256 + wr * 64 + fr, colb = u.pn * 256 + wc * 32 + 8 * fq;
#pragma unroll
        for (int ai = 0; ai < 2; ++ai)
#pragma unroll
            for (int m = 0; m < 4; ++m) { bf16_t* rp = ACT + (size_t)(row0 + ai * 128 + m * 16) * 8192 + colb;
#pragma unroll
                for (int bj = 0; bj < 2; ++bj) { f32x4 v0 = acc[ai][bj][m][0], v1 = acc[ai][bj][m][1];
#pragma unroll
                    for (int j = 0; j < 4; ++j) { const float a = fmaxf(v0[j], 0.f), b = fmaxf(v1[j], 0.f); v0[j] = a * a; v1[j] = b * b; }
                    u32x4 w; w.x = pk2(v0[0], v0[1]); w.y = pk2(v0[2], v0[3]); w.z = pk2(v1[0], v1[1]); w.w = pk2(v1[2], v1[3]);
                    *(u32x4*)(rp + bj * 128) = w; } }
    }
};

__device__ __forceinline__ float wave_sum(float v) {
#pragma unroll
    for (int o = 1; o < 64; o <<= 1) v += __shfl_xor(v, o);
    return v;
}
__device__ __forceinline__ void rms_row(const float* xrow, const float* g, float* copy_dst, bf16_t* hrow, float* yrow, int lane) {
    f32x4 v[8]; float s = 0.f;
#pragma unroll
    for (int j = 0; j < 8; ++j) { v[j] = *((const f32x4*)xrow + lane + 64 * j); s += (v[j][0] * v[j][0] + v[j][1] * v[j][1]) + (v[j][2] * v[j][2] + v[j][3] * v[j][3]); }
    const float rstd = 1.0f / sqrtf(wave_sum(s) * (1.0f / 2048.0f) + EPS);
#pragma unroll
    for (int j = 0; j < 8; ++j) {
        const f32x4 gg = *((const f32x4*)g + lane + 64 * j);
        if (copy_dst) *((f32x4*)copy_dst + lane + 64 * j) = v[j];
        const f32x4 o = v[j] * rstd * gg;
        if (hrow) { u32x2 w; w.x = pk2(o[0], o[1]); w.y = pk2(o[2], o[3]); *((u32x2*)hrow + lane + 64 * j) = w; }
        if (yrow) *((f32x4*)yrow + lane + 64 * j) = o;
    }
}
__device__ __forceinline__ void transpose_item(const float* W, int K, int N, bf16_t* WT, LAS float* scr, int item, int lane) {
    const int nblk = N / 32, kb = item / nblk, nb = item % nblk, k0 = 64 * kb, n0 = 32 * nb;
    {
        f32x4 t[8];
#pragma unroll
        for (int i = 0; i < 8; ++i) t[i] = *(const f32x4*)(W + (size_t)(k0 + 8 * i + (lane >> 3)) * N + n0 + 4 * (lane & 7));
#pragma unroll
        for (int i = 0; i < 8; ++i) { LAS float* d = scr + (8 * i + (lane >> 3)) * 33 + 4 * (lane & 7); d[0] = t[i][0]; d[1] = t[i][1]; d[2] = t[i][2]; d[3] = t[i][3]; }
    }
    LDS_FENCE();
    const int c = lane & 7;
#pragma unroll
    for (int j = 0; j < 4; ++j) { const int n = (lane >> 3) + 8 * j; const LAS float* s = scr + (8 * c) * 33 + n;
        u32x4 o; o.x = pk2(s[0 * 33], s[1 * 33]); o.y = pk2(s[2 * 33], s[3 * 33]); o.z = pk2(s[4 * 33], s[5 * 33]); o.w = pk2(s[6 * 33], s[7 * 33]);
        *(u32x4*)(WT + (size_t)(n0 + n) * K + k0 + 8 * c) = o; }
    LDS_FENCE();
}
constexpr int I_IN = 32 * 160, I_GLU = 16 * 32, I_OUT = 32 * 64, I_F1 = 32 * 256, I_F2 = 128 * 64, I_L = I_IN + I_GLU + I_OUT + I_F1 + I_F2;
__device__ __forceinline__ void conv_item(const Params& p, LAS float* scr, int l, int r, int lane) {
    if (r < I_IN) { transpose_item(p.w_in + (size_t)l * D * INC, D, INC, (bf16_t*)(p.ws + OFF_WIN + l * SZ_WIN), scr, r, lane); return; } r -= I_IN;
    if (r < I_GLU) { transpose_item(p.w_glu + (size_t)l * 1024 * 1024, 1024, 1024, (bf16_t*)(p.ws + OFF_WGLU + l * SZ_WGLU), scr, r, lane); return; } r -= I_GLU;
    if (r < I_OUT) { transpose_item(p.w_out + (size_t)l * D * D, D, D, (bf16_t*)(p.ws + OFF_WOUT + l * SZ_WOUT), scr, r, lane); return; } r -= I_OUT;
    if (r < I_F1) { transpose_item(p.w_ff1 + (size_t)l * D * DFF, D, DFF, (bf16_t*)(p.ws + OFF_WFF1 + l * SZ_WFF1), scr, r, lane); return; } r -= I_F1;
    transpose_item(p.w_ff2 + (size_t)l * DFF * D, DFF, D, (bf16_t*)(p.ws + OFF_WFF2 + l * SZ_WFF2), scr, r, lane);
}
__device__ __forceinline__ void bg_convert(LAS unsigned char* lds, const Params& p, int first_idle, int l, int start, int count) {
    if (gridDim.x != 256) return;
    const int bid = obid(); if (bid < first_idle) return;
    const int tid = otid(), lane = tid & 63, w = tid >> 6;
    LAS float* scr = (LAS float*)(lds + w * 8448);
    const int nw = (256 - first_idle) * 8;
    for (int i = (bid - first_idle) * 8 + w; i < count; i += nw) conv_item(p, scr, l, start + i, lane);
}
constexpr int BG_A_START = 5632, BG_A_N = 4224, BG_B_START = 9856, BG_B_N = 3840, BG_O_START = 13696, BG_O_N = 2176, BG_P0_START = 15872, BG_P0_N = 0, BG_C_START = 15872, BG_C_N = 8192;
constexpr int BG_C0_EXTRA = 2560, BG_F0_START = 2560, BG_F0_N = 3072;
static_assert(BG_A_START + BG_A_N == BG_B_START && BG_B_START + BG_B_N == BG_O_START && BG_O_START + BG_O_N == BG_P0_START && BG_P0_START + BG_P0_N == BG_C_START && BG_C_START + BG_C_N == I_L, "schedule covers the layer");
static_assert(BG_C0_EXTRA == BG_F0_START && BG_F0_START + BG_F0_N == BG_A_START, "schedule covers layer 1's first matrices");
__device__ __forceinline__ void phase0(LAS unsigned char* lds, const Params& p) {
    const int tid = otid(), lane = tid & 63, w = tid >> 6;
    const int gw = obid() * 8 + w, NGW = gridDim.x * 8;
    LAS float* scr = (LAS float*)(lds + w * 8448);
    if (gridDim.x == 256) {
        for (int it = gw; it < BG_A_START + 2 * BG_P0_N; it += NGW) {
            if (it < BG_A_START) conv_item(p, scr, 0, it, lane);
            else if (it < BG_A_START + BG_P0_N) conv_item(p, scr, 0, BG_P0_START + (it - BG_A_START), lane);
            else conv_item(p, scr, 1, BG_P0_START + (it - BG_A_START - BG_P0_N), lane);
        }
    }
    bf16_t* H = (bf16_t*)(p.ws + OFF_H);
    for (int r = gw; r < M; r += NGW) {
        const float* src = r < 8192 ? p.x_prompt + (size_t)r * D : p.x_sample + (size_t)(r - 8192) * D;
        rms_row(src, p.norm1_g, p.out + (size_t)r * D, H + (size_t)r * D, nullptr, lane);
    }
    if (obid() == 0) {
        float* LB = (float*)(p.ws + OFF_LB);
        for (int c = tid; c < 1024; c += 512) { const float l0 = p.lb_logits[c], l1 = p.lb_logits[1024 + c]; LB[c] = 0.f; LB[1024 + c] = 1.0f / (1.0f + expf(l0 - l1)); }
    }
}
__device__ __forceinline__ void phase_norm_parts(const Params& p, const float* g, bool final_, const float* part, int splits) {
    const int tid_ = otid(); const int lane = tid_ & 63, w = tid_ >> 6;
    bf16_t* H = (bf16_t*)(p.ws + OFF_H);
    const int G = gridDim.x;
    for (int r = obid() * 8 + w; r < M; r += G * 8) {
        float* xr = p.out + (size_t)r * D;
        const int pm = r >> 8;
        unsigned long long code = 0ull;
        if (G == 256) { for (int j = 0; j < 16; ++j) { pg8::StaticOrder T; T.init(M, D, G, j); pg8::Unit u; T.next(1, u); if (u.pm == pm) code |= (unsigned long long)(j + 1) << (8 * u.pn); } }
        f32x4 v[8]; float s = 0.f;
#pragma unroll
        for (int j = 0; j < 8; ++j) {
            v[j] = *((const f32x4*)xr + lane + 64 * j);
            const int lj = (int)((code >> (8 * j)) & 0xffull);
            if (lj) { const float* pp = part + (size_t)(lj - 1) * splits * 65536 + (size_t)(r & 255) * 256 + 4 * lane;
                for (int ks = 0; ks < splits; ++ks) v[j] = v[j] + *(const f32x4*)(pp + (size_t)ks * 65536);
                if (!final_) *((f32x4*)xr + lane + 64 * j) = v[j]; }
            s += (v[j][0] * v[j][0] + v[j][1] * v[j][1]) + (v[j][2] * v[j][2] + v[j][3] * v[j][3]);
        }
        const float rstd = 1.0f / sqrtf(wave_sum(s) * (1.0f / 2048.0f) + EPS);
#pragma unroll
        for (int j = 0; j < 8; ++j) {
            const f32x4 gg = *((const f32x4*)g + lane + 64 * j);
            const f32x4 o = v[j] * rstd * gg;
            if (final_) *((f32x4*)xr + lane + 64 * j) = o;
            else { u32x2 wv; wv.x = pk2(o[0], o[1]); wv.y = pk2(o[2], o[3]); *((u32x2*)(H + (size_t)r * D) + lane + 64 * j) = wv; }
        }
    }
}
__device__ __forceinline__ void phase_norm(const Params& p, const float* g, bool final_) {
    const int tid_ = otid(); const int lane = tid_ & 63, w = tid_ >> 6;
    bf16_t* H = (bf16_t*)(p.ws + OFF_H);
    for (int r = obid() * 8 + w; r < M; r += gridDim.x * 8) {
        float* xr = p.out + (size_t)r * D;
        if (final_) rms_row(xr, g, nullptr, nullptr, xr, lane); else rms_row(xr, g, nullptr, H + (size_t)r * D, nullptr, lane);
    }
}

constexpr int H_QT = 0, H_KT = 17408, H_ATT = 34816, H_VT = 44032, H_ST = 62464, H_KHT = 97280, H_CUM = 115712, H_SEG = 149504, H_SSQ = 153600;
#define MFMA16(a, b, c) __builtin_amdgcn_mfma_f32_16x16x32_bf16(a, b, c, 0, 0, 0)
#define FRAG(off) (*(const LAS bf16x8*)(lds + (off)))
struct HItem { int b, h, nvalid, rbase, pidx; };
__device__ __forceinline__ HItem hgrn_decode(int item) {
    HItem r;
    if (item < 1024) { const int bh = item >> 5, c = item & 31; r.b = bh >> 3; r.h = bh & 7; r.nvalid = 64; r.rbase = r.b * 2048 + c * 64; r.pidx = item; }
    else { const int j = item - 1024; r.b = j >> 3; r.h = j & 7; r.nvalid = 32; r.rbase = 8192 + r.b * 32; r.pidx = -1; }
    return r;
}
__device__ __forceinline__ void hgrn_load_vt(LAS unsigned char* lds, const bf16_t* Vp, int rbase, int nvalid, int tid) {
    const int s2 = (tid & 31) * 2, c0 = (tid >> 5) * 8;
    u32x4 a = (u32x4){0u, 0u, 0u, 0u}, b = a;
    if (s2 < nvalid) a = *(const u32x4*)(Vp + (size_t)(rbase + s2) * 1024 + c0);
    if (s2 + 1 < nvalid) b = *(const u32x4*)(Vp + (size_t)(rbase + s2 + 1) * 1024 + c0);
    LAS unsigned* vt = (LAS unsigned*)(lds + H_VT + c0 * 144 + s2 * 2);
#pragma unroll
    for (int j = 0; j < 4; ++j) {
        vt[(2 * j) * 36] = (a[j] & 0xffffu) | (b[j] << 16);
        vt[(2 * j + 1) * 36] = (a[j] >> 16) | (b[j] & 0xffff0000u);
    }
}
__device__ __forceinline__ void hgrn_m1_item(LAS unsigned char* lds, const Params& p, int l, int item) {
    const int tid = otid(), lane = tid & 63, w = tid >> 6, q4 = lane >> 4, l15 = lane & 15;
    const HItem I = hgrn_decode(item);
    const float* LFp = (const float*)(p.ws + OFF_LOGF) + I.h * 128;
    const bf16_t* Vp = (const bf16_t*)(p.ws + OFF_V) + I.h * 128;
    LAS float* SEGf = (LAS float*)(lds + H_SEG);
    {
        const int kcol = tid & 127, seg = tid >> 7;
        float lf[16], c[16];
#pragma unroll
        for (int i = 0; i < 16; ++i) { const int t = seg * 16 + i; lf[i] = (t < I.nvalid) ? LFp[(size_t)(I.rbase + t) * 1024 + kcol] : 0.f; }
        hgrn_load_vt(lds, Vp, I.rbase, I.nvalid, tid);
        c[0] = lf[0];
#pragma unroll
        for (int i = 1; i < 16; ++i) c[i] = c[i - 1] + lf[i];
        SEGf[seg * 128 + kcol] = c[15];
        __syncthreads();
        const float s0 = SEGf[kcol], s1 = SEGf[128 + kcol], s2 = SEGf[256 + kcol], s3 = SEGf[384 + kcol];
        const float off = (seg > 0 ? s0 : 0.f) + (seg > 1 ? s1 : 0.f) + (seg > 2 ? s2 : 0.f);
        const float last = (s0 + s1) + (s2 + s3), ref = s0 + s1;
        if (seg == 0) {
            const float el = __expf(last);
            SEGf[768 + kcol] = el;
            if (I.pidx >= 0) { float* dec = (float*)(p.ws + OFF_DEC) + (size_t)I.pidx * 256; st_dev_f32(dec + kcol, el); st_dev_f32(dec + 128 + kcol, __expf(ref)); }
        }
        unsigned pk[8];
#pragma unroll
        for (int i = 0; i < 16; i += 2) {
            const float c0 = off + c[i], c1 = off + c[i + 1];
            const float k0 = (1.0f - __expf(lf[i])) * __expf(last - c0), k1 = (1.0f - __expf(lf[i + 1])) * __expf(last - c1);
            pk[i >> 1] = pk2(k0, k1);
        }
        LAS u32x4* kd = (LAS u32x4*)(lds + H_KHT + kcol * 144 + seg * 32);
        kd[0] = (u32x4){pk[0], pk[1], pk[2], pk[3]}; kd[1] = (u32x4){pk[4], pk[5], pk[6], pk[7]};
    }
    __syncthreads();
    {
        bf16x8 ka[2];
#pragma unroll
        for (int ks = 0; ks < 2; ++ks) ka[ks] = FRAG(H_KHT + (16 * w + l15) * 144 + (32 * ks + 8 * q4) * 2);
        if (I.pidx >= 0) {
            bf16_t* ds = (bf16_t*)(p.ws + OFF_DS) + (size_t)I.pidx * 16384;
#pragma unroll
            for (int vt = 0; vt < 8; ++vt) { f32x4 s = (f32x4){0.f, 0.f, 0.f, 0.f};
#pragma unroll
                for (int ks = 0; ks < 2; ++ks) { const bf16x8 bv = FRAG(H_VT + (16 * vt + l15) * 144 + (32 * ks + 8 * q4) * 2); s = MFMA16(ka[ks], bv, s); }
                MFMA_SETTLE();
                u32x2 o; o.x = pk2(s[0], s[1]); o.y = pk2(s[2], s[3]);
                st_dev_u32x2(ds + (16 * vt + l15) * 128 + 16 * w + 4 * q4, o); }
        } else {
            const f32x4 el = *(const LAS f32x4*)(lds + H_SEG + 3072 + (16 * w + 4 * q4) * 4);
            const float* sin_ = p.state_hgrn + ((size_t)(l * 16 + I.b) * 8 + I.h) * 16384;
            float* sout = p.out + OUT_HS + ((size_t)(l * 16 + I.b) * 8 + I.h) * 16384;
#pragma unroll
            for (int vt = 0; vt < 8; ++vt) { f32x4 s;
#pragma unroll
                for (int j = 0; j < 4; ++j) s[j] = sin_[(16 * w + 4 * q4 + j) * 128 + 16 * vt + l15] * el[j];
#pragma unroll
                for (int ks = 0; ks < 2; ++ks) { const bf16x8 bv = FRAG(H_VT + (16 * vt + l15) * 144 + (32 * ks + 8 * q4) * 2); s = MFMA16(ka[ks], bv, s); }
                MFMA_SETTLE();
#pragma unroll
                for (int j = 0; j < 4; ++j) sout[(16 * w + 4 * q4 + j) * 128 + 16 * vt + l15] = s[j]; }
        }
    }
    __syncthreads();
}
__device__ __forceinline__ void hgrn_m2(const Params& p, int l) {
    const int gt = obid() * 512 + otid(), GT = gridDim.x * 512;
    for (int idx = gt; idx < 32 * 128 * 32; idx += GT) {
        const int bh = idx >> 12, v = (idx >> 5) & 127, k4 = (idx & 31) * 4;
        const bf16_t* ds = (const bf16_t*)(p.ws + OFF_DS) + (size_t)bh * 32 * 16384 + v * 128 + k4;
        const float* dec = (const float*)(p.ws + OFF_DEC) + (size_t)bh * 32 * 256 + k4;
        bf16_t* sp = (bf16_t*)(p.ws + OFF_SP) + (size_t)bh * 32 * 16384 + v * 128 + k4;
        f32x4 S = (f32x4){0.f, 0.f, 0.f, 0.f};
#pragma unroll 8
        for (int c = 0; c < 32; ++c) {
            const u32x2 e0_ = ld_dev_u32x2(dec + c * 256), e1_ = ld_dev_u32x2(dec + c * 256 + 2), r0_ = ld_dev_u32x2(dec + c * 256 + 128), r1_ = ld_dev_u32x2(dec + c * 256 + 130);
            const f32x4 el = (f32x4){__uint_as_float(e0_.x), __uint_as_float(e0_.y), __uint_as_float(e1_.x), __uint_as_float(e1_.y)}, er = (f32x4){__uint_as_float(r0_.x), __uint_as_float(r0_.y), __uint_as_float(r1_.x), __uint_as_float(r1_.y)};
            const u32x2 dw = ld_dev_u32x2(ds + (size_t)c * 16384);
            const f32x4 d4 = (f32x4){bf_lo(dw.x), bf_hi(dw.x), bf_lo(dw.y), bf_hi(dw.y)};
            u32x2 o; o.x = pk2(S[0] * er[0], S[1] * er[1]); o.y = pk2(S[2] * er[2], S[3] * er[3]);
            st_dev_u32x2(sp + (size_t)c * 16384, o);
            S = S * el + d4;
        }
        float* so = p.out + OUT_HP + ((size_t)(l * 32 + bh)) * 16384;
#pragma unroll
        for (int j = 0; j < 4; ++j) so[(k4 + j) * 128 + v] = S[j];
    }
}
__device__ __forceinline__ void hgrn_m3_item(LAS unsigned char* lds, const Params& p, int l, int item) {
    const int tid = otid(), lane = tid & 63, w = tid >> 6, q4 = lane >> 4, l15 = lane & 15;
    const HItem I = hgrn_decode(item);
    const bf16_t* Qp = (const bf16_t*)(p.ws + OFF_Q) + I.h * 128; const float* LFp = (const float*)(p.ws + OFF_LOGF) + I.h * 128;
    const bf16_t* Vp = (const bf16_t*)(p.ws + OFF_V) + I.h * 128; const bf16_t* Gp = (const bf16_t*)(p.ws + OFF_G) + I.h * 128;
    bf16_t* MIXp = (bf16_t*)(p.ws + OFF_MIX) + I.h * 128;
    const float* og = p.onorm_g + l * 1024 + I.h * 128;
    LAS float* SEGf = (LAS float*)(lds + H_SEG); LAS float* CUMf = (LAS float*)(lds + H_CUM); LAS float* SSQf = (LAS float*)(lds + H_SSQ);
    const int rbase = I.rbase, nvalid = I.nvalid;
    const int tB = tid >> 3, k0B = (tid & 7) * 16; const bool validB = tB < nvalid;
    f32x4 qv[4], lv[4];
#pragma unroll
    for (int i = 0; i < 4; ++i) { qv[i] = (f32x4){0.f, 0.f, 0.f, 0.f}; lv[i] = qv[i];
        if (validB) { const u32x2 qw = *(const u32x2*)(Qp + (size_t)(rbase + tB) * 1024 + k0B + 4 * i); qv[i] = (f32x4){bf_lo(qw.x), bf_hi(qw.x), bf_lo(qw.y), bf_hi(qw.y)};
            lv[i] = *(const f32x4*)(LFp + (size_t)(rbase + tB) * 1024 + k0B + 4 * i); } }
    u32x4 spv[4];
    {
        const bool zero = (I.pidx < 0) || ((I.pidx & 31) == 0);
        const char* sp = (const char*)((const bf16_t*)(p.ws + OFF_SP) + (size_t)(I.pidx < 0 ? 0 : I.pidx) * 16384);
#pragma unroll
        for (int i = 0; i < 4; ++i) { const int id = tid + 512 * i; spv[i] = (u32x4){0u, 0u, 0u, 0u};
            if (!zero) spv[i] = *(const u32x4*)(sp + (size_t)id * 16); }
    }
    {
        const int kcol = tid & 127, seg = tid >> 7;
        float c[16];
#pragma unroll
        for (int i = 0; i < 16; ++i) { const int t = seg * 16 + i; c[i] = (t < nvalid) ? LFp[(size_t)(rbase + t) * 1024 + kcol] : 0.f; }
        hgrn_load_vt(lds, Vp, rbase, nvalid, tid);
#pragma unroll
        for (int i = 1; i < 16; ++i) c[i] = c[i - 1] + c[i];
        SEGf[seg * 128 + kcol] = c[15];
        __syncthreads();
        const float s0 = SEGf[kcol], s1 = SEGf[128 + kcol], s2 = SEGf[256 + kcol];
        const float off = (seg > 0 ? s0 : 0.f) + (seg > 1 ? s1 : 0.f) + (seg > 2 ? s2 : 0.f);
        const float ref = s0 + s1;
        if (seg == 0) { SEGf[512 + kcol] = ref; SEGf[640 + kcol] = __expf(ref); }
#pragma unroll
        for (int i = 0; i < 16; ++i) CUMf[(seg * 16 + i) * 132 + kcol] = off + c[i];
    }
    __syncthreads();
    {
        unsigned qpk[8], kpk[8];
#pragma unroll
        for (int i = 0; i < 4; ++i) {
            const f32x4 cu = *(const LAS f32x4*)(lds + H_CUM + (tB * 132 + k0B + 4 * i) * 4), rf = *(const LAS f32x4*)(lds + H_SEG + 2048 + (k0B + 4 * i) * 4);
            float qt[4], kt[4];
#pragma unroll
            for (int j = 0; j < 4; ++j) { const float d = cu[j] - rf[j]; qt[j] = qv[i][j] * __expf(d); kt[j] = (1.0f - __expf(lv[i][j])) * __expf(-d); }
            qpk[2 * i] = pk2(qt[0], qt[1]); qpk[2 * i + 1] = pk2(qt[2], qt[3]); kpk[2 * i] = pk2(kt[0], kt[1]); kpk[2 * i + 1] = pk2(kt[2], kt[3]);
        }
        LAS u32x4* qd = (LAS u32x4*)(lds + H_QT + tB * 272 + k0B * 2); qd[0] = (u32x4){qpk[0], qpk[1], qpk[2], qpk[3]}; qd[1] = (u32x4){qpk[4], qpk[5], qpk[6], qpk[7]};
        LAS u32x4* kd = (LAS u32x4*)(lds + H_KT + tB * 272 + k0B * 2); kd[0] = (u32x4){kpk[0], kpk[1], kpk[2], kpk[3]}; kd[1] = (u32x4){kpk[4], kpk[5], kpk[6], kpk[7]};
    }
    if (I.pidx >= 0) {
#pragma unroll
        for (int i = 0; i < 4; ++i) { const int id = tid + 512 * i, row = id >> 4, c16 = id & 15; *(LAS u32x4*)(lds + H_ST + row * 272 + c16 * 16) = spv[i]; }
    } else {
        const float* sin_ = p.state_hgrn + ((size_t)(l * 16 + I.b) * 8 + I.h) * 16384;
        const f32x4 er = *(const LAS f32x4*)(lds + H_SEG + 2560 + (16 * w + 4 * q4) * 4);
#pragma unroll
        for (int vt = 0; vt < 8; ++vt) { float s[4];
#pragma unroll
            for (int j = 0; j < 4; ++j) s[j] = sin_[(16 * w + 4 * q4 + j) * 128 + 16 * vt + l15] * er[j];
            u32x2 o; o.x = pk2(s[0], s[1]); o.y = pk2(s[2], s[3]);
            *(LAS u32x2*)(lds + H_ST + (16 * vt + l15) * 272 + (16 * w + 4 * q4) * 2) = o; }
    }
    __syncthreads();
    {
        const int tt = w >> 1;
#pragma unroll
        for (int u = 0; u < 2; ++u) {
            const int st = 2 * (w & 1) + u;
            u32x2 o = (u32x2){0u, 0u};
            if (st <= tt) {
                f32x4 acc = (f32x4){0.f, 0.f, 0.f, 0.f};
#pragma unroll
                for (int ks = 0; ks < 4; ++ks) { const bf16x8 a = FRAG(H_KT + (16 * st + l15) * 272 + (32 * ks + 8 * q4) * 2), bq = FRAG(H_QT + (16 * tt + l15) * 272 + (32 * ks + 8 * q4) * 2); acc = MFMA16(a, bq, acc); }
                MFMA_SETTLE();
                const int tg = 16 * tt + l15, sg = 16 * st + 4 * q4;
                const float a0 = (sg + 0 <= tg) ? acc[0] : 0.f, a1 = (sg + 1 <= tg) ? acc[1] : 0.f, a2 = (sg + 2 <= tg) ? acc[2] : 0.f, a3 = (sg + 3 <= tg) ? acc[3] : 0.f;
                o.x = pk2(a0, a1); o.y = pk2(a2, a3);
            }
            *(LAS u32x2*)(lds + H_ATT + (16 * tt + l15) * 144 + (16 * st + 4 * q4) * 2) = o;
        }
    }
    __syncthreads();
    f32x4 O[4];
    const int tt = w & 3, vh = w >> 2, t = 16 * tt + l15;
    u32x2 gg[4]; f32x4 g4[4];
#pragma unroll
    for (int i = 0; i < 4; ++i) { const int vb = 16 * (4 * vh + i) + 4 * q4; g4[i] = *(const f32x4*)(og + vb);
        gg[i] = (t < nvalid) ? *(const u32x2*)(Gp + (size_t)(rbase + t) * 1024 + vb) : (u32x2){0u, 0u}; }
    {
        bf16x8 ab[2], qb[4];
#pragma unroll
        for (int ks = 0; ks < 2; ++ks) ab[ks] = FRAG(H_ATT + (16 * tt + l15) * 144 + (32 * ks + 8 * q4) * 2);
#pragma unroll
        for (int ks = 0; ks < 4; ++ks) qb[ks] = FRAG(H_QT + (16 * tt + l15) * 272 + (32 * ks + 8 * q4) * 2);
        float ssq = 0.f;
#pragma unroll
        for (int i = 0; i < 4; ++i) {
            const int vt = 4 * vh + i; f32x4 acc = (f32x4){0.f, 0.f, 0.f, 0.f};
#pragma unroll
            for (int ks = 0; ks < 2; ++ks) { const bf16x8 a = FRAG(H_VT + (16 * vt + l15) * 144 + (32 * ks + 8 * q4) * 2); acc = MFMA16(a, ab[ks], acc); }
#pragma unroll
            for (int ks = 0; ks < 4; ++ks) { const bf16x8 a = FRAG(H_ST + (16 * vt + l15) * 272 + (32 * ks + 8 * q4) * 2); acc = MFMA16(a, qb[ks], acc); }
            MFMA_SETTLE();
            O[i] = acc; ssq += (acc[0] * acc[0] + acc[1] * acc[1]) + (acc[2] * acc[2] + acc[3] * acc[3]);
        }
        ssq += __shfl_xor(ssq, 16); ssq += __shfl_xor(ssq, 32);
        if (q4 == 0) SSQf[vh * 64 + 16 * tt + l15] = ssq;
    }
    __syncthreads();
    {
        const float tot = SSQf[t] + SSQf[64 + t];
        const float rs = 1.0f / sqrtf(tot * (1.0f / 128.0f) + EPS);
        if (t < nvalid) {
#pragma unroll
            for (int i = 0; i < 4; ++i) { const int vb = 16 * (4 * vh + i) + 4 * q4;
                u32x2 o; o.x = pk2(O[i][0] * rs * g4[i][0] * bf_lo(gg[i].x), O[i][1] * rs * g4[i][1] * bf_hi(gg[i].x)); o.y = pk2(O[i][2] * rs * g4[i][2] * bf_lo(gg[i].y), O[i][3] * rs * g4[i][3] * bf_hi(gg[i].y));
                *(u32x2*)(MIXp + (size_t)(rbase + t) * 2048 + vb) = o; }
        }
    }
    __syncthreads();
}

__device__ __forceinline__ void s5_lbar(const Params& p, int gi, int n, float& lbr, float& lbi, float& cr, float& ci) {
    const float dt = expf(p.log_step[gi]);
    const float lr = p.lam_re[gi * 64 + n], li = p.lam_im[gi * 64 + n];
    const float mag = expf(dt * lr), ang = dt * li;
    const float kq = rintf(ang * 0.636619772f);
    float r = fmaf(-kq, 1.57079637f, ang); r = fmaf(-kq, -4.37113883e-8f, r);
    const int qi = ((int)kq) & 3;
    const float r2 = r * r;
    const float sn = r + r * r2 * (-1.66666667e-1f + r2 * (8.33333333e-3f + r2 * (-1.98412698e-4f + r2 * 2.75573192e-6f)));
    const float cs = 1.0f + r2 * (-0.5f + r2 * (4.16666667e-2f + r2 * (-1.38888889e-3f + r2 * (2.48015873e-5f + r2 * -2.75573192e-7f))));
    const float s_ = (qi == 0) ? sn : (qi == 1) ? cs : (qi == 2) ? -sn : -cs;
    const float c_ = (qi == 0) ? cs : (qi == 1) ? -sn : (qi == 2) ? -cs : sn;
    lbr = mag * c_; lbi = mag * s_;
    const float nr = lbr - 1.0f, ni = lbi, den = lr * lr + li * li;
    cr = (nr * lr + ni * li) / den; ci = (ni * lr - nr * li) / den;
}
template <int KIND>
__device__ __forceinline__ void s5_wave(LAS unsigned char* lds  , const Params& p, int l, int b, int g, int cc, int lane) {
    const int n = lane, q4 = lane >> 4, l15 = lane & 15;
    const int nsteps = KIND == 2 ? 32 : 256, row0 = KIND == 2 ? 8192 + b * 32 : b * 2048 + cc * 256;
    const int gi = l * 64 + g;
    float lbr, lbi, cr, ci;
    s5_lbar(p, gi, n, lbr, lbi, cr, ci);
    {
        const f32x4* Brp = (const f32x4*)(p.B_re + ((size_t)gi * 64 + n) * 16); const f32x4* Bip = (const f32x4*)(p.B_im + ((size_t)gi * 64 + n) * 16);
        unsigned re[8], im[8];
#pragma unroll
        for (int i = 0; i < 4; ++i) { const f32x4 br = Brp[i], bi = Bip[i];
            re[2 * i] = pk2(cr * br[0] - ci * bi[0], cr * br[1] - ci * bi[1]); re[2 * i + 1] = pk2(cr * br[2] - ci * bi[2], cr * br[3] - ci * bi[3]);
            im[2 * i] = pk2(cr * bi[0] + ci * br[0], cr * bi[1] + ci * br[1]); im[2 * i + 1] = pk2(cr * bi[2] + ci * br[2], cr * bi[3] + ci * br[3]); }
        LAS u32x4* d0 = (LAS u32x4*)(lds + n * 32); d0[0] = (u32x4){re[0], re[1], re[2], re[3]}; d0[1] = (u32x4){re[4], re[5], re[6], re[7]};
        LAS u32x4* d1 = (LAS u32x4*)(lds + (64 + n) * 32); d1[0] = (u32x4){im[0], im[1], im[2], im[3]}; d1[1] = (u32x4){im[4], im[5], im[6], im[7]};
    }
    LDS_FENCE();
    const bf16x8 zero8 = (bf16x8){0, 0, 0, 0, 0, 0, 0, 0};
    bf16x8 bbf[8];
#pragma unroll
    for (int j = 0; j < 8; ++j) { const bf16x8 t = *(const LAS bf16x8*)(lds + (16 * j + l15) * 32 + (q4 & 1) * 16); bbf[j] = (q4 < 2) ? t : zero8; }
    LDS_FENCE();
    bf16x8 cf[4]; f32x4 dv = (f32x4){0.f, 0.f, 0.f, 0.f};
    if (KIND != 0) {
#pragma unroll
        for (int ks = 0; ks < 4; ++ks) {
            const size_t ci_ = ((size_t)gi * 16 + l15) * 64 + 16 * ks + 4 * q4;
            const f32x4 cr4 = *(const f32x4*)(p.C_re + ci_), ci4 = *(const f32x4*)(p.C_im + ci_);
            const u32x4 wv = (u32x4){pk2(cr4[0], -ci4[0]), pk2(cr4[1], -ci4[1]), pk2(cr4[2], -ci4[2]), pk2(cr4[3], -ci4[3])};
            cf[ks] = __builtin_bit_cast(bf16x8, wv);
        }
        dv = *(const f32x4*)(p.s5_D + l * 1024 + g * 16 + 4 * q4);
    }
    float xr = 0.f, xi = 0.f;
    const size_t eidx = ((size_t)(b * 64 + g) * 8 + cc) * 64 + n;
    if (KIND == 1) {
        float ar = lbr, ai = lbi;
#pragma unroll
        for (int i = 0; i < 8; ++i) { const float nr = ar * ar - ai * ai, ni = 2.0f * ar * ai; ar = nr; ai = ni; }
        const float* se = (const float*)(p.ws + OFF_S5E); const size_t e0 = ((size_t)(b * 64 + g) * 8) * 64 + n;
        for (int j = 0; j < cc; ++j) { const float er = ld_dev_f32(se + e0 + j * 64), ei = ld_dev_f32(se + 131072 + e0 + j * 64);
            const float nxr = ar * xr - ai * xi + er, nxi = ar * xi + ai * xr + ei; xr = nxr; xi = nxi; }
    }
    if (KIND == 2) { xr = p.state_re[((size_t)(l * 16 + b) * 64 + g) * 64 + n]; xi = p.state_im[((size_t)(l * 16 + b) * 64 + g) * 64 + n]; }
    const bf16_t* Up = (const bf16_t*)(p.ws + OFF_U) + g * 16;
    bf16_t* HHp = (bf16_t*)(p.ws + OFF_HH) + g * 16;
    LAS float* BUf = (LAS float*)lds; LAS unsigned short* X16 = (LAS unsigned short*)(lds + 8448);
    u32x4 nu = (u32x4){0u, 0u, 0u, 0u};
    if (q4 < 2) nu = *(const u32x4*)(Up + (size_t)(row0 + l15) * 1024 + 8 * q4);
    for (int t0 = 0; t0 < nsteps; t0 += 16) {
        const bf16x8 uf = __builtin_bit_cast(bf16x8, nu);
        if (q4 < 2 && t0 + 16 < nsteps) nu = *(const u32x4*)(Up + (size_t)(row0 + t0 + 16 + l15) * 1024 + 8 * q4);
        const size_t row = (size_t)(row0 + t0 + l15);
        f32x4 u4 = (f32x4){0.f, 0.f, 0.f, 0.f};
        if (KIND != 0) { const u32x2 uw = *(const u32x2*)(Up + row * 1024 + 4 * q4); u4 = (f32x4){bf_lo(uw.x), bf_hi(uw.x), bf_lo(uw.y), bf_hi(uw.y)}; }
        f32x4 dd[8];
#pragma unroll
        for (int j = 0; j < 8; ++j) dd[j] = MFMA16(bbf[j], uf, ((f32x4){0.f, 0.f, 0.f, 0.f}));
        MFMA_SETTLE();
#pragma unroll
        for (int j = 0; j < 8; ++j) *(LAS f32x4*)(lds + (l15 * 132 + 16 * j + 4 * q4) * 4) = dd[j];
        LDS_FENCE();
#pragma unroll
        for (int t = 0; t < 16; ++t) {
            const float br = BUf[t * 132 + n], bi = BUf[t * 132 + 64 + n];
            const float nxr = fmaf(lbr, xr, fmaf(-lbi, xi, br)), nxi = fmaf(lbr, xi, fmaf(lbi, xr, bi));
            xr = nxr; xi = nxi;
            if (KIND != 0) *(LAS unsigned*)(lds + 8448 + t * 272 + n * 4) = pk2(xr, xi);
        }
        LDS_FENCE();
        if (KIND != 0) {
            f32x4 y = (f32x4){0.f, 0.f, 0.f, 0.f};
#pragma unroll
            for (int ks = 0; ks < 4; ++ks) { const bf16x8 xb = *(const LAS bf16x8*)(lds + 8448 + l15 * 272 + (32 * ks + 8 * q4) * 2); y = MFMA16(cf[ks], xb, y); }
            MFMA_SETTLE();
            LDS_FENCE();
            float hh[4];
#pragma unroll
            for (int j = 0; j < 4; ++j) { const float yy = y[j] + dv[j] * u4[j]; const float a = 0.7978845608028654f * (yy + 0.044715f * yy * yy * yy);
                const float e = __expf(2.0f * a); const float th = 1.0f - 2.0f / (e + 1.0f); hh[j] = 0.5f * yy * (1.0f + th); }
            u32x2 o; o.x = pk2(hh[0], hh[1]); o.y = pk2(hh[2], hh[3]);
            *(u32x2*)(HHp + row * 1024 + 4 * q4) = o;
        }
    }
    if (KIND == 0) { float* se = (float*)(p.ws + OFF_S5E); st_dev_f32(se + eidx, xr); st_dev_f32(se + 131072 + eidx, xi); }
    if (KIND == 1 && cc == 7) { const size_t o = ((size_t)(l * 4 + b) * 64 + g) * 64 + n; p.out[OUT_RP + o] = xr; p.out[OUT_IP + o] = xi; }
    if (KIND == 2) { const size_t idx = ((size_t)(l * 16 + b) * 64 + g) * 64 + n; p.out[OUT_RS + idx] = xr; p.out[OUT_IS + idx] = xi; }
}
__device__ __forceinline__ void phase_mix1(LAS unsigned char* lds, const Params& p, int l) {
    const int tid_ = otid(); const int w = tid_ >> 6, lane = tid_ & 63;
    for (int it = obid(); it < 1152 + 256; it += gridDim.x) {
        if (it < 1152) hgrn_m1_item(lds, p, l, it);
        else { const int id = (it - 1152) * 8 + w;
            s5_wave<0>(lds + w * 12800, p, l, id >> 9, id & 63, (id >> 6) & 7, lane); __syncthreads(); }
    }
}
__device__ __forceinline__ void phase_mix2(const Params& p, int l) { hgrn_m2(p, l); }
__device__ __forceinline__ void phase_mix3(LAS unsigned char* lds, const Params& p, int l) {
    const int tid_ = otid(); const int w = tid_ >> 6, lane = tid_ & 63;
    for (int it = obid(); it < 1152 + 256 + 128; it += gridDim.x) {
        if (it < 1152) hgrn_m3_item(lds, p, l, it);
        else if (it < 1152 + 128) { const int id = (it - 1152) * 8 + w;
            s5_wave<2>(lds + w * 12800, p, l, id >> 6, id & 63, 0, lane); __syncthreads(); }
        else { const int id = (it - 1152 - 128) * 8 + w;
            s5_wave<1>(lds + w * 12800, p, l, id >> 9, id & 63, (id >> 6) & 7, lane); __syncthreads(); }
    }
}

__device__ __forceinline__ void gemm_residual(LAS unsigned char* lds, const Params& p, const bf16_t* A, const bf16_t* Bt, int K, float* part, int splits) {
    const int G = gridDim.x, bid = obid();
    pg8::StaticOrder S; S.init(M, D, G, bid);
    EpiRes E; E.X = p.out;
    if (G != 256) { pg8::gemm_phase(lds, pg8::Gemm{A, Bt, M, D, K, K}, S, E); return; }
    pg8::OneUnit S1; S1.valid = S.next(0, S1.u);
    pg8::gemm_phase(lds, pg8::Gemm{A, Bt, M, D, K, K}, S1, E);
    const int j = bid / splits, ks = bid % splits, Ksub = K / splits;
    pg8::OneUnit S2; S2.valid = false;
    if (j < 16) { pg8::StaticOrder T; T.init(M, D, G, j); S2.valid = T.next(1, S2.u); }
    EpiPart EP; EP.P = part + (size_t)(j * splits + ks) * 65536;
    pg8::gemm_phase(lds, pg8::Gemm{A + (size_t)ks * Ksub, Bt + (size_t)ks * Ksub, M, D, Ksub, K}, S2, EP);
}

__device__ __forceinline__ void run_phase(LAS unsigned char* lds, const Params& p, int ph) {
    if (ph == 0) { if (PH_MASK & 256) phase0(lds, p); return; }
    const int l = (ph - 1) / 10, s = (ph - 1) % 10;
    pg8::StaticOrder S;
    bf16_t* H = (bf16_t*)(p.ws + OFF_H); bf16_t* MIX = (bf16_t*)(p.ws + OFF_MIX); bf16_t* HH = (bf16_t*)(p.ws + OFF_HH); bf16_t* ACT = (bf16_t*)(p.ws + OFF_R);
    switch (s) {
    case 0: if (PH_MASK & 1) { S.init(M, INC, gridDim.x, obid());
        EpiIn E; E.Q = (float*)(p.ws + OFF_Q); E.LOGF = (float*)(p.ws + OFF_LOGF); E.U = (float*)(p.ws + OFF_U); E.V = (bf16_t*)(p.ws + OFF_V); E.G = (bf16_t*)(p.ws + OFF_G); E.LB = (const float*)(p.ws + OFF_LB) + l * 1024;
        pg8::gemm_phase(lds, pg8::Gemm{H, (const bf16_t*)(p.ws + OFF_WIN + l * SZ_WIN), M, INC, D, D}, S, E);
        bg_convert(lds, p, 168, l, BG_A_START, BG_A_N); } break;
    case 1: if (PH_MASK & 2) phase_mix1(lds, p, l); break;
    case 2: if (PH_MASK & 2) phase_mix2(p, l); break;
    case 3: if (PH_MASK & 2) phase_mix3(lds, p, l); break;
    case 4: if (PH_MASK & 4) { S.init(M, 1024, gridDim.x, obid());
        EpiGlu E; E.MIX = MIX; E.HH = HH; E.bias = p.b_glu + l * 1024;
        pg8::gemm_phase(lds, pg8::Gemm{HH, (const bf16_t*)(p.ws + OFF_WGLU + l * SZ_WGLU), M, 1024, 1024, 1024}, S, E);
        bg_convert(lds, p, 136, l, BG_B_START, BG_B_N); } break;
    case 5: if (PH_MASK & 8) { gemm_residual(lds, p, MIX, (const bf16_t*)(p.ws + OFF_WOUT + l * SZ_WOUT), D, (float*)(p.ws + OFF_HH), 4);
        bg_convert(lds, p, 64, l, BG_O_START, BG_O_N); } break;
    case 6: if (PH_MASK & 16) phase_norm_parts(p, p.norm2_g + l * D, false, (const float*)(p.ws + OFF_HH), 4); break;
    case 7: if (PH_MASK & 32) { S.init(M, DFF, gridDim.x, obid());
        EpiFF1 E; E.ACT = ACT;
        pg8::gemm_phase(lds, pg8::Gemm{H, (const bf16_t*)(p.ws + OFF_WFF1 + l * SZ_WFF1), M, DFF, D, D}, S, E);
        bg_convert(lds, p, 64, l, BG_C_START, BG_C_N); if (l == 0) bg_convert(lds, p, 64, 1, 0, BG_C0_EXTRA); } break;
    case 8: if (PH_MASK & 64) { gemm_residual(lds, p, ACT, (const bf16_t*)(p.ws + OFF_WFF2 + l * SZ_WFF2), DFF, (float*)(p.ws + OFF_MIX), 8);
        if (l == 0) bg_convert(lds, p, 128, 1, BG_F0_START, BG_F0_N); } break;
    default: if (PH_MASK & 128) { if (l == 0) phase_norm_parts(p, p.norm1_g + D, false, (const float*)(p.ws + OFF_MIX), 8); else phase_norm_parts(p, p.final_g, true, (const float*)(p.ws + OFF_MIX), 8); } break;
    }
}

struct BarState { unsigned* w; unsigned xid, cen, nx, k; };
__device__ __forceinline__ void grid_barrier(BarState& B) {
    asm volatile("s_waitcnt vmcnt(0) lgkmcnt(0)" ::: "memory");
    __syncthreads();
    if (threadIdx.x < 64) {
        if (threadIdx.x == 0) {
            const unsigned k = ++B.k;
            const unsigned o = __hip_atomic_fetch_add(B.w + 64 * (9 + B.xid), 1u, __ATOMIC_RELAXED, __HIP_MEMORY_SCOPE_AGENT) + 1u;
            if (o == k * B.cen) {
                __builtin_amdgcn_fence(__ATOMIC_RELEASE, "agent"); asm volatile("s_waitcnt vmcnt(0)" ::: "memory");
                const unsigned t = __hip_atomic_fetch_add(B.w + 64 * 17, 1u, __ATOMIC_RELAXED, __HIP_MEMORY_SCOPE_AGENT) + 1u;
                if (t == k * B.nx) __hip_atomic_store(B.w + 64 * 18, k, __ATOMIC_RELAXED, __HIP_MEMORY_SCOPE_AGENT);
            }
            while (__hip_atomic_load(B.w + 64 * 18, __ATOMIC_RELAXED, __HIP_MEMORY_SCOPE_AGENT) < k) __builtin_amdgcn_s_sleep(BAR_SLEEP);
        }
        __builtin_amdgcn_fence(__ATOMIC_ACQUIRE, "agent"); asm volatile("s_waitcnt vmcnt(0)" ::: "memory");
    }
    __syncthreads();
}
__global__ void __launch_bounds__(512, 2) mega(Params p) {
    extern __shared__ __attribute__((aligned(16))) unsigned char shm[];
    LAS unsigned char* lds = (LAS unsigned char*)shm;
    cg::grid_group grid = cg::this_grid();
    BarState B; B.w = (unsigned*)(p.ws + OFF_BAR); B.xid = (unsigned)__builtin_amdgcn_s_getreg((3 << 11) | 20) & 7u; B.cen = 0; B.nx = 0; B.k = 0;
    if (threadIdx.x == 0) __hip_atomic_fetch_add(B.w + 64 * (1 + B.xid), 1u, __ATOMIC_RELAXED, __HIP_MEMORY_SCOPE_AGENT);
    grid.sync();
    if (threadIdx.x == 0) {
        for (unsigned j = 0; j < 8; ++j) { const unsigned c = __hip_atomic_load(B.w + 64 * (1 + j), __ATOMIC_RELAXED, __HIP_MEMORY_SCOPE_AGENT); if (j == B.xid) B.cen = c; B.nx += (c != 0u) ? 1u : 0u; }
    }
    for (int i = 0; i < EXTRA_BARS; ++i) grid_barrier(B);
    for (int ph = p.ph_lo; ph < p.ph_hi; ++ph) {
        run_phase(lds, p, ph);
        if (ph + 1 < p.ph_hi) grid_barrier(B);
    }
}

extern "C" void kernel_launch(void* const* d_in, const int* in_sizes, int n_in, void* d_out, int out_size, void* d_ws, size_t ws_size, hipStream_t stream) {
    static int grid_blocks = 0;
    if (!grid_blocks) {
        int dev = 0, cus = 0, per_cu = 0;
        hipGetDevice(&dev);
        hipDeviceGetAttribute(&cus, hipDeviceAttributeMultiprocessorCount, dev);
        if (hipFuncSetAttribute((const void*)mega, hipFuncAttributeMaxDynamicSharedMemorySize, LDS_BYTES) != hipSuccess) fprintf(stderr, "hipFuncSetAttribute failed\n");
        if (hipOccupancyMaxActiveBlocksPerMultiprocessor(&per_cu, (const void*)mega, 512, LDS_BYTES) != hipSuccess || per_cu < 1) { fprintf(stderr, "occupancy query: %d\n", per_cu); per_cu = 1; }
        (void)hipGetLastError();
        if (per_cu > 1) per_cu = 1;
        grid_blocks = cus * per_cu;
        if (grid_blocks != 256) { fprintf(stderr, "this kernel's work schedule is built for 256 co-resident workgroups (one per CU of a 256-CU device); got %d; nothing launched\n", grid_blocks); grid_blocks = -1; }
        else if (ws_size < WS_END) { fprintf(stderr, "workspace too small: %zu < %zu; nothing launched\n", ws_size, (size_t)WS_END); grid_blocks = -1; }
    }
    if (grid_blocks < 0) return;
    (void)hipMemsetAsync((unsigned char*)d_ws + OFF_BAR, 0, 8192, stream);
    Params p{};
    const float** pf = (const float**)&p;
    for (int i = 0; i < 24; ++i) pf[i] = (const float*)d_in[i];
    p.out = (float*)d_out; p.ws = (unsigned char*)d_ws;
#if ONE_LAUNCH
    p.ph_lo = 0; p.ph_hi = NPH;
    { void* args[] = {&p};
      hipError_t e = hipLaunchCooperativeKernel((const void*)mega, dim3(grid_blocks), dim3(512), args, LDS_BYTES, stream);
      if (e != hipSuccess) fprintf(stderr, "cooperative launch failed: %s (grid %d)\n", hipGetErrorString(e), grid_blocks); }
#else
    for (int ph = 0; ph < NPH; ++ph) {
        p.ph_lo = ph; p.ph_hi = ph + 1;
        void* args[] = {&p};
        hipError_t e = hipLaunchCooperativeKernel((const void*)mega, dim3(grid_blocks), dim3(512), args, LDS_BYTES, stream);
        if (e != hipSuccess) { fprintf(stderr, "launch %d failed: %s (grid %d)\n", ph, hipGetErrorString(e), grid_blocks); break; }
    }
#endif
}
```
